# Optimizing an MI355X kernel written in HIP

```python
import jax, jax.numpy as jnp
from jax import lax
import numpy as np

D_MODEL = 1024
BATCH = 8
SEQ = 4096
DEPTH = 4

GRID_W = 64
CTX_LEN = 256
N_MOD = 6
NORM_EPS = 1e-6
ATT_HEADS = 8
ATT_KV_HEADS = 2
HEAD_DIM = 64
WINDOW = 128
ATT_BLOCK = 128
ROPE_BASE = 10000.0
ROPE_PAIRS = HEAD_DIM // 4
ATT_Q = ATT_HEADS * HEAD_DIM
ATT_KV = ATT_KV_HEADS * HEAD_DIM
MLSTM_HEADS = 4
MLSTM_HEAD_DIM = 64
MLSTM_CHUNK = 64
M_W = MLSTM_HEADS * MLSTM_HEAD_DIM
M_GATES = 4 * MLSTM_HEADS
LRU_WIDTH = 256
LRU_BLOCKS = 4
LRU_BW = LRU_WIDTH // LRU_BLOCKS
LRU_C = 8.0
CONV_WIDTH = 4
CONV_LEFT = CONV_WIDTH // 2
D_IN = ATT_Q + 2 * ATT_KV + 4 * M_W + M_GATES + 2 * LRU_WIDTH
D_MIX = ATT_Q + M_W + LRU_WIDTH
D_FF = -(-8 * D_MODEL // (3 * 256)) * 256

kernel_name = "hybrid_prefix_dit_mlstm_rglru_swa"


def rms_norm(x, g):
    xf = x.astype(jnp.float32)
    y = xf * lax.rsqrt(jnp.mean(xf * xf, axis=-1, keepdims=True) + NORM_EPS)
    return (y * g.astype(jnp.float32)).astype(x.dtype)


def modulate(h, shift, scale):
    return h * (1 + scale) + shift


def flip_streams(a, n_ctx):
    return jnp.concatenate([a[:, :n_ctx][:, ::-1], a[:, n_ctx:][:, ::-1]], axis=1)


def rotate(x, cos, sin):
    x1, x2 = jnp.split(x, 2, axis=-1)
    cos, sin = cos.astype(x.dtype), sin.astype(x.dtype)
    return jnp.concatenate([x1 * cos - x2 * sin, x2 * cos + x1 * sin], axis=-1)


def rope_axial(x, rope):
    cos_r, sin_r, cos_c, sin_c = rope
    half = HEAD_DIM // 2
    return jnp.concatenate([rotate(x[..., :half], cos_r, sin_r), rotate(x[..., half:], cos_c, sin_c)], axis=-1)


def windowed_gqa(q_l, k_l, v_l, q_c, k_c, v_c, sink, rope, need_ctx):
    B, S, _ = q_l.shape
    n_ctx = k_c.shape[1]
    G = ATT_HEADS // ATT_KV_HEADS
    scale = HEAD_DIM ** -0.5
    f32 = jnp.float32
    q = rope_axial(q_l.reshape(B, S, ATT_HEADS, HEAD_DIM), rope) * scale
    k = rope_axial(k_l.reshape(B, S, ATT_KV_HEADS, HEAD_DIM), rope)
    v = v_l.reshape(B, S, ATT_KV_HEADS, HEAD_DIM)
    kc = k_c.reshape(B, n_ctx, ATT_KV_HEADS, HEAD_DIM)
    vc = v_c.reshape(B, n_ctx, ATT_KV_HEADS, HEAD_DIM)
    nb = S // ATT_BLOCK
    qb = q.reshape(B, nb, ATT_BLOCK, ATT_KV_HEADS, G, HEAD_DIM)

    def band(a):
        ap = jnp.pad(a, ((0, 0), (ATT_BLOCK, ATT_BLOCK), (0, 0), (0, 0)))
        ap = ap.reshape(B, nb + 2, ATT_BLOCK, ATT_KV_HEADS, HEAD_DIM)
        return jnp.concatenate([ap[:, :-2], ap[:, 1:-1], ap[:, 2:]], axis=2)

    kw, vw = band(k), band(v)
    blk = jnp.arange(nb)[:, None, None] * ATT_BLOCK
    qpos = blk + jnp.arange(ATT_BLOCK)[None, :, None]
    kpos = blk - ATT_BLOCK + jnp.arange(3 * ATT_BLOCK)[None, None, :]
    valid = (jnp.abs(qpos - kpos) <= WINDOW) & (kpos >= 0) & (kpos < S)
    s_loc = jnp.einsum('bnqkgd,bnskd->bnkgqs', qb, kw).astype(f32)
    s_loc = jnp.where(valid[None, :, None, None], s_loc, -jnp.inf)
    s_ctx = jnp.einsum('bnqkgd,bckd->bnkgqc', qb, kc).astype(f32)
    sink_h = sink.astype(f32).reshape(ATT_KV_HEADS, G, 1, 1)
    s_sink = jnp.broadcast_to(sink_h, s_loc.shape[:-1] + (1,))
    p = jax.nn.softmax(jnp.concatenate([s_loc, s_ctx, s_sink], axis=-1), axis=-1).astype(v.dtype)
    L = 3 * ATT_BLOCK
    o = (jnp.einsum('bnkgqs,bnskd->bnqkgd', p[..., :L], vw)
         + jnp.einsum('bnkgqc,bckd->bnqkgd', p[..., L:L + n_ctx], vc))
    out_l = o.reshape(B, S, ATT_Q)
    out_c = None
    if need_ctx:
        qc = q_c.reshape(B, n_ctx, ATT_KV_HEADS, G, HEAD_DIM) * scale
        s = jnp.einsum('bqkgd,bckd->bkgqc', qc, kc).astype(f32)
        s = jnp.concatenate([s, jnp.broadcast_to(sink_h, s.shape[:-1] + (1,))], axis=-1)
        pc = jax.nn.softmax(s, axis=-1).astype(vc.dtype)
        out_c = jnp.einsum('bkgqc,bckd->bqkgd', pc[..., :n_ctx], vc).reshape(B, n_ctx, ATT_Q)
    return out_l, out_c


def mlstm_chunkwise(q, k, v, log_i, log_f):
    B, T, H, dh = q.shape
    L = MLSTM_CHUNK
    N = T // L
    to_chunks = lambda a: jnp.moveaxis(a.reshape(B, N, L, H, -1), 3, 1)
    qc, kc, vc = to_chunks(q), to_chunks(k), to_chunks(v)
    li = jnp.moveaxis(log_i.reshape(B, N, L, H), 3, 1)
    lf = jnp.moveaxis(log_f.reshape(B, N, L, H), 3, 1)
    b = jnp.cumsum(lf, axis=-1)
    g = b[..., -1]
    a = g[..., None] - b + li
    m_loc = jnp.max(a, axis=-1)
    w = jnp.exp(a - m_loc[..., None])
    C_loc = jnp.einsum('bhnl,bhnld,bhnle->bhnde', w, kc, vc)
    n_loc = jnp.einsum('bhnl,bhnld->bhnd', w, kc)

    def step(carry, xs):
        C, n, m = carry
        g_j, m_j, C_j, n_j = xs
        m_new = jnp.maximum(g_j + m, m_j)
        f_prev = jnp.exp(g_j + m - m_new)
        f_loc = jnp.exp(m_j - m_new)
        C_new = f_prev[..., None, None] * C + f_loc[..., None, None] * C_j
        n_new = f_prev[..., None] * n + f_loc[..., None] * n_j
        return (C_new, n_new, m_new), (C, n, m)

    init = (jnp.zeros((B, H, dh, dh), q.dtype), jnp.zeros((B, H, dh), q.dtype), jnp.zeros((B, H), q.dtype))
    xs = (jnp.moveaxis(g, 2, 0), jnp.moveaxis(m_loc, 2, 0), jnp.moveaxis(C_loc, 2, 0), jnp.moveaxis(n_loc, 2, 0))
    _, (C0, n0, m0) = lax.scan(step, init, xs)
    C0, n0, m0 = jnp.moveaxis(C0, 0, 2), jnp.moveaxis(n0, 0, 2), jnp.moveaxis(m0, 0, 2)
    tril = jnp.tril(jnp.ones((L, L), dtype=bool))
    d_log = jnp.where(tril, b[..., :, None] - b[..., None, :] + li[..., None, :], -jnp.inf)
    m_inter = b + m0[..., None]
    m_t = jnp.maximum(jnp.max(d_log, axis=-1), m_inter)
    f_inter = jnp.exp(m_inter - m_t)
    s = jnp.einsum('bhntd,bhnsd->bhnts', qc, kc) * jnp.exp(d_log - m_t[..., None])
    num = (f_inter[..., None] * jnp.einsum('bhntd,bhnde->bhnte', qc, C0)
           + jnp.einsum('bhnts,bhnse->bhnte', s, vc))
    den = f_inter * jnp.einsum('bhntd,bhnd->bhnt', qc, n0) + jnp.sum(s, axis=-1)
    h = num / jnp.maximum(jnp.abs(den), jnp.exp(-m_t))[..., None]
    return jnp.moveaxis(h, 1, 3).reshape(B, T, H, dh)


def head_norm(h, g):
    mu = jnp.mean(h, axis=-1, keepdims=True)
    var = jnp.mean(jnp.square(h - mu), axis=-1, keepdims=True)
    y = (h - mu) * lax.rsqrt(var + NORM_EPS)
    return y.reshape(h.shape[0], h.shape[1], -1) * g.astype(jnp.float32)


def mlstm_mixer(q_l, k_l, v_l, o_l, g_l, q_c, k_c, v_c, o_c, g_c, gate_b, norm_g, need_ctx):
    n_ctx = q_c.shape[1]
    f32 = jnp.float32
    heads = lambda a: a.astype(f32).reshape(a.shape[0], a.shape[1], MLSTM_HEADS, MLSTM_HEAD_DIM)
    gates = lambda a: a.astype(f32).reshape(a.shape[0], a.shape[1], 4, MLSTM_HEADS) + gate_b.astype(f32)
    q = jnp.concatenate([heads(q_c), heads(q_l)], axis=1)
    k = jnp.concatenate([heads(k_c), heads(k_l)], axis=1) * (MLSTM_HEAD_DIM ** -0.5)
    v = jnp.concatenate([heads(v_c), heads(v_l)], axis=1)
    gt = jnp.concatenate([gates(g_c), gates(g_l)], axis=1)
    h_f = mlstm_chunkwise(q, k, v, gt[:, :, 0], jax.nn.log_sigmoid(gt[:, :, 1]))
    fl = lambda a: flip_streams(a, n_ctx)
    h_b = fl(mlstm_chunkwise(fl(q), fl(k), fl(v), fl(gt[:, :, 2]), fl(jax.nn.log_sigmoid(gt[:, :, 3]))))
    h = h_f + h_b
    finish = lambda hh, o: (jax.nn.sigmoid(o.astype(f32)) * head_norm(hh, norm_g)).astype(o.dtype)
    out_l = finish(h[:, n_ctx:], o_l)
    out_c = finish(h[:, :n_ctx], o_c) if need_ctx else None
    return out_l, out_c


def dwconv(x, w, b):
    T = x.shape[1]
    xp = jnp.pad(x, ((0, 0), (CONV_LEFT, CONV_WIDTH - 1 - CONV_LEFT), (0, 0)))
    return b + sum(w[j] * xp[:, j:j + T] for j in range(CONV_WIDTH))


def block_diag(x, w):
    B, T, _ = x.shape
    y = jnp.einsum('btni,nij->btnj', x.reshape(B, T, LRU_BLOCKS, LRU_BW), w)
    return y.reshape(B, T, LRU_WIDTH)


def linear_scan(a, u):
    def comb(lhs, rhs):
        al, ul = lhs
        ar, ur = rhs
        return al * ar, ar * ul + ur
    _, h = lax.associative_scan(comb, (a, u), axis=1)
    return h


def rglru_mixer(x_l, y_l, x_c, y_c, conv_w, conv_b, gate_w, gate_b, lam, need_ctx):
    n_ctx = x_c.shape[1]
    f32 = jnp.float32
    cw, cb = conv_w.astype(f32), conv_b.astype(f32)
    seq = jnp.concatenate([dwconv(x_c.astype(f32), cw, cb), dwconv(x_l.astype(f32), cw, cb)], axis=1)
    h = 0.0
    for d in range(2):
        r = jax.nn.sigmoid(block_diag(seq, gate_w[d, 0].astype(f32)) + gate_b[d, 0].astype(f32))
        i = jax.nn.sigmoid(block_diag(seq, gate_w[d, 1].astype(f32)) + gate_b[d, 1].astype(f32))
        log_a = -LRU_C * r * jax.nn.softplus(-lam[d].astype(f32))
        a = jnp.exp(log_a)
        u = jnp.sqrt(-jnp.expm1(2.0 * log_a)) * (i * seq)
        if d == 0:
            h = h + linear_scan(a, u)
        else:
            h = h + flip_streams(linear_scan(flip_streams(a, n_ctx), flip_streams(u, n_ctx)), n_ctx)
    out_l = (h[:, n_ctx:] * jax.nn.gelu(y_l.astype(f32))).astype(x_l.dtype)
    out_c = (h[:, :n_ctx] * jax.nn.gelu(y_c.astype(f32))).astype(x_c.dtype) if need_ctx else None
    return out_l, out_c


def token_mixers(p_l, p_c, rope, sink, m_gate_b, m_norm, conv_w, conv_b, lru_w, lru_b, lru_lam, need_ctx):
    sizes = [ATT_Q, ATT_KV, ATT_KV, M_W, M_W, M_W, M_W, M_GATES, LRU_WIDTH, LRU_WIDTH]
    pts = np.cumsum(sizes)[:-1].tolist()
    aq, ak, av, mq, mk, mv, mo, mg, rx, ry = jnp.split(p_l, pts, axis=-1)
    cq, ck, cv, cmq, cmk, cmv, cmo, cmg, crx, cry = jnp.split(p_c, pts, axis=-1)
    att_l, att_c = windowed_gqa(aq, ak, av, cq, ck, cv, sink, rope, need_ctx)
    mem_l, mem_c = mlstm_mixer(mq, mk, mv, mo, mg, cmq, cmk, cmv, cmo, cmg, m_gate_b, m_norm, need_ctx)
    rec_l, rec_c = rglru_mixer(rx, ry, crx, cry, conv_w, conv_b, lru_w, lru_b, lru_lam, need_ctx)
    out_l = jnp.concatenate([att_l, mem_l, rec_l], axis=-1)
    out_c = jnp.concatenate([att_c, mem_c, rec_c], axis=-1) if need_ctx else None
    return out_l, out_c


def swiglu(h, w_in, w_out):
    gate, up = jnp.split(h @ w_in, 2, axis=-1)
    return (jax.nn.silu(gate) * up) @ w_out


def setup_inputs(seed: int = 0) -> dict:
    key = jax.random.key(seed)
    ks = jax.random.split(key, 20)
    f32 = jnp.float32
    nrm = lambda k, shape, s: jax.random.normal(k, shape, f32) * s
    x = nrm(ks[0], (BATCH, SEQ, D_MODEL), 1.0)
    c = nrm(ks[1], (BATCH, D_MODEL), 1.0)
    ctx = nrm(ks[2], (BATCH, CTX_LEN, D_MODEL), 1.0)
    c_ctx = nrm(ks[3], (D_MODEL,), 1.0)
    w_ada = nrm(ks[4], (DEPTH, D_MODEL, N_MOD * D_MODEL), 0.5 * D_MODEL ** -0.5)
    b_ada = nrm(ks[5], (DEPTH, N_MOD * D_MODEL), 0.01)
    norm_gain = 1.0 + nrm(ks[6], (DEPTH, 4, D_MODEL), 0.05)
    w_in = nrm(ks[7], (DEPTH, D_MODEL, D_IN), D_MODEL ** -0.5)
    w_out = nrm(ks[8], (DEPTH, D_MIX, D_MODEL), D_MIX ** -0.5)
    attn_sink = nrm(ks[9], (DEPTH, ATT_HEADS), 0.5)
    i_bias = nrm(ks[10], (DEPTH, 2, MLSTM_HEADS), 0.1)
    f_bias = 3.0 + 3.0 * jax.random.uniform(ks[11], (DEPTH, 2, MLSTM_HEADS), f32)
    mlstm_gate_b = jnp.stack([i_bias[:, 0], f_bias[:, 0], i_bias[:, 1], f_bias[:, 1]], axis=1)
    mlstm_norm = 1.0 + nrm(ks[12], (DEPTH, M_W), 0.05)
    conv_w = nrm(ks[13], (DEPTH, CONV_WIDTH, LRU_WIDTH), CONV_WIDTH ** -0.5)
    conv_b = nrm(ks[14], (DEPTH, LRU_WIDTH), 0.01)
    lru_gate_w = nrm(ks[15], (DEPTH, 2, 2, LRU_BLOCKS, LRU_BW, LRU_BW), LRU_BW ** -0.5)
    lru_gate_b = nrm(ks[16], (DEPTH, 2, 2, LRU_WIDTH), 0.01)
    a_c = jax.random.uniform(ks[17], (DEPTH, 2, LRU_WIDTH), f32, 0.9, 0.999)
    p = a_c ** (1.0 / LRU_C)
    lru_lam = jnp.log(p) - jnp.log1p(-p)
    w_ffn_in = nrm(ks[18], (DEPTH, D_MODEL, 2 * D_FF), D_MODEL ** -0.5)
    w_ffn_out = nrm(ks[19], (DEPTH, D_FF, D_MODEL), D_FF ** -0.5)
    return {"x": x, "c": c, "ctx": ctx, "c_ctx": c_ctx, "w_ada": w_ada, "b_ada": b_ada,
            "norm_gain": norm_gain, "w_in": w_in, "w_out": w_out, "attn_sink": attn_sink,
            "mlstm_gate_b": mlstm_gate_b, "mlstm_norm": mlstm_norm, "conv_w": conv_w, "conv_b": conv_b,
            "lru_gate_w": lru_gate_w, "lru_gate_b": lru_gate_b, "lru_lam": lru_lam,
            "w_ffn_in": w_ffn_in, "w_ffn_out": w_ffn_out}


def reference(x, c, ctx, c_ctx, w_ada, b_ada, norm_gain, w_in, w_out, attn_sink, mlstm_gate_b, mlstm_norm,
              conv_w, conv_b, lru_gate_w, lru_gate_b, lru_lam, w_ffn_in, w_ffn_out):
    n_lat = x.shape[1]
    n_rows = n_lat // GRID_W
    t = jnp.arange(n_rows * GRID_W)
    row = (t // GRID_W).astype(jnp.float32)
    col = (t % GRID_W).astype(jnp.float32)
    freqs = ROPE_BASE ** (-jnp.arange(ROPE_PAIRS, dtype=jnp.float32) / ROPE_PAIRS)
    ang_r = (row[:, None] * freqs)[:, None, :]
    ang_c = (col[:, None] * freqs)[:, None, :]
    rope = (jnp.cos(ang_r), jnp.sin(ang_r), jnp.cos(ang_c), jnp.sin(ang_c))
    s_lat = jax.nn.silu(c)
    s_ctx = jax.nn.silu(c_ctx)
    for l in range(DEPTH):
        need_ctx = l < DEPTH - 1
        mod_l = jnp.split((s_lat @ w_ada[l] + b_ada[l])[:, None, :], N_MOD, axis=-1)
        mod_c = jnp.split(s_ctx @ w_ada[l] + b_ada[l], N_MOD, axis=-1)
        h_l = modulate(rms_norm(x, norm_gain[l, 0]), mod_l[0], mod_l[1])
        h_c = modulate(rms_norm(ctx, norm_gain[l, 0]), mod_c[0], mod_c[1])
        mix_l, mix_c = token_mixers(h_l @ w_in[l], h_c @ w_in[l], rope, attn_sink[l], mlstm_gate_b[l], mlstm_norm[l],
                                    conv_w[l], conv_b[l], lru_gate_w[l], lru_gate_b[l], lru_lam[l], need_ctx)
        x = x + mod_l[2] * rms_norm(mix_l @ w_out[l], norm_gain[l, 1])
        f_l = swiglu(modulate(rms_norm(x, norm_gain[l, 2]), mod_l[3], mod_l[4]), w_ffn_in[l], w_ffn_out[l])
        x = x + mod_l[5] * rms_norm(f_l, norm_gain[l, 3])
        if need_ctx:
            ctx = ctx + mod_c[2] * rms_norm(mix_c @ w_out[l], norm_gain[l, 1])
            f_c = swiglu(modulate(rms_norm(ctx, norm_gain[l, 2]), mod_c[3], mod_c[4]), w_ffn_in[l], w_ffn_out[l])
            ctx = ctx + mod_c[5] * rms_norm(f_c, norm_gain[l, 3])
    return x
```

```cpp
#include <hip/hip_runtime.h>
#include <hip/hip_cooperative_groups.h>
#include <cstdio>
#include <cstdint>
namespace cg = cooperative_groups;
namespace pg8 {
#define PG8_LAS __attribute__((address_space(3)))
typedef unsigned short bf16_t;
typedef short bf16x8 __attribute__((ext_vector_type(8)));
typedef float f32x4 __attribute__((ext_vector_type(4)));
typedef unsigned u32x4 __attribute__((ext_vector_type(4)));
constexpr int BM = 256, BK = 64, HALF = 128, HTB = HALF * BK * 2  , STAGE_BYTES = 8 * HTB, NXCD = 8, WGM = 8;

__host__ __device__ __forceinline__ int lds_byte(int r, int c) { const int st = (r >> 4) * 2 + (c >> 5), rr = r & 15, cc = c & 31, ob = rr * 64 + cc * 2; return st * 1024 + (ob ^ (((ob >> 9) & 1) << 5)); }
__host__ __device__ __forceinline__ void stage_rc(int b, int& R, int& C) { const int st = b / 1024, sb = b % 1024, swz = sb ^ (((sb >> 9) & 1) << 5); R = (st >> 1) * 16 + swz / 64; C = (st & 1) * 32 + (swz % 64) / 2; }
__host__ __device__ __forceinline__ int perm32(int rho) { const int n = rho >> 4, i = rho & 15; return 8 * (i >> 2) + 4 * n + (i & 3); }

struct Unit { int pm, pn; };
struct Gemm { const bf16_t* A; const bf16_t* Bt; int M, N, K; };

struct StaticOrder {
    int nM, nN, nwg, G, c, skipc;
    __host__ __device__ void init(int M, int N, int G_, int c_, int skipc_ = 0) { nM = skipc_ ? (M / BM) / 17 * 16 : M / BM; nN = N / BM; nwg = nM * nN; G = G_; c = c_; skipc = skipc_; }
    __host__ __device__ bool next(int i, Unit& u) const {
        const long L = (long)i * G + c; if (L >= nwg) return false;
        int wgid = (int)L; { const int q = nwg / NXCD, r = nwg % NXCD, xcd = wgid % NXCD, off = wgid / NXCD; wgid = (xcd < r ? xcd * (q + 1) : r * (q + 1) + (xcd - r) * q) + off; }
        const int nig = WGM * nN, gid = wgid / nig, fm = gid * WGM, gsz = (nM - fm) < WGM ? (nM - fm) : WGM;
        u.pm = fm + ((wgid % nig) % gsz); u.pn = (wgid % nig) / gsz; if (skipc) u.pm = (u.pm >> 4) * 17 + 1 + (u.pm & 15); return true;
    }
    __device__ __forceinline__ void a_ready(const Unit&) const {}
    __device__ __forceinline__ void done(const Unit&) const {}
};

typedef __bf16 bf16x2_cv __attribute__((ext_vector_type(2)));
typedef float f32x2_cv __attribute__((ext_vector_type(2)));
__device__ __forceinline__ unsigned cvt_pk_bf16(float lo, float hi) { const f32x2_cv v = {lo, hi}; const bf16x2_cv b = __builtin_convertvector(v, bf16x2_cv); return __builtin_bit_cast(unsigned, b); }
typedef float f32x2 __attribute__((ext_vector_type(2)));
template <class Epi, class Sched, bool ALIGN_EPI = false, bool SP2 = false>
__device__ __forceinline__ void gemm_phase(PG8_LAS unsigned char* lds, const Gemm g, const Sched& S, const Epi& E) {
    int tid_l = threadIdx.x; asm volatile("" : "+v"(tid_l)); const int tid = tid_l, wid = __builtin_amdgcn_readfirstlane(tid >> 6), lane = tid & 63, wr = wid >> 2, wc = wid & 3, fr = lane & 15, fq = lane >> 4;
    const int K = g.K, nt = K / BK;
    unsigned voffA[2], voffB[2];
#pragma unroll
    for (int i = 0; i < 2; ++i) { int R, C; stage_rc(tid * 16 + i * 8192, R, C); const int Rb = Epi::PERM ? ((R & ~31) + perm32(R & 31)) : R;
        voffA[i] = (unsigned)(R * K + C) * 2u; voffB[i] = (unsigned)(Rb * K + C) * 2u; }
    const size_t kstep = (size_t)(BK * 2);
    const size_t hstep = (size_t)HALF * K * 2;
    const size_t tstep = 2 * hstep;
    const unsigned ldsw = (unsigned)wid * 1024u;
    const int aoff = lds_byte(wr * 64 + fr, fq * 8), boff = lds_byte(wc * 32 + fr, fq * 8);
#define PG8_SA(b, h) (((b) * 2 + (h)) * HTB)
#define PG8_SB(b, h) ((4 + (b) * 2 + (h)) * HTB)
#define PG8_STAGE(bufoff, gbase, voff) do { _Pragma("unroll") for (int _i = 0; _i < 2; ++_i) \
        __builtin_amdgcn_global_load_lds((const unsigned*)((const char*)(gbase) + (voff)[_i]), (PG8_LAS unsigned*)(lds + (bufoff) + ldsw + _i * 8192), 16, 0, 0); } while (0)
#define PG8_LDA(dst, b, h) do { _Pragma("unroll") for (int m = 0; m < 4; ++m) _Pragma("unroll") for (int k = 0; k < 2; ++k) dst[m][k] = *(const PG8_LAS bf16x8*)(lds + PG8_SA(b, h) + aoff + m * 2048 + k * 1024); } while (0)
#define PG8_LDB(dst, b, h) do { _Pragma("unroll") for (int n = 0; n < 2; ++n) _Pragma("unroll") for (int k = 0; k < 2; ++k) dst[n][k] = *(const PG8_LAS bf16x8*)(lds + PG8_SB(b, h) + boff + n * 2048 + k * 1024); } while (0)
#define PG8_MMA(ai, bj, At, Bt) do { __builtin_amdgcn_s_setprio(1); _Pragma("unroll") for (int m = 0; m < 4; ++m) _Pragma("unroll") for (int n = 0; n < 2; ++n) _Pragma("unroll") for (int k = 0; k < 2; ++k) \
        acc[ai][bj][m][n] = __builtin_amdgcn_mfma_f32_16x16x32_bf16(Bt[n][k], At[m][k], acc[ai][bj][m][n], 0, 0, 0); __builtin_amdgcn_s_setprio(0); } while (0)
#define PG8_WAIT_V(n) asm volatile("s_waitcnt vmcnt(" #n ")" ::: "memory")
#define PG8_WAIT_L(n) asm volatile("s_waitcnt lgkmcnt(" #n ")" ::: "memory")
#define PG8_BAR __builtin_amdgcn_s_barrier()
#define PG8_SCHED __builtin_amdgcn_sched_barrier(0)
    Unit cur, nxt; int ui = 0;
    if (!S.next(0, cur)) return;
    f32x4 acc[2][2][4][2];
#pragma unroll
    for (int a = 0; a < 2; ++a)
#pragma unroll
        for (int b = 0; b < 2; ++b)
#pragma unroll
            for (int m = 0; m < 4; ++m)
#pragma unroll
                for (int n = 0; n < 2; ++n) acc[a][b][m][n] = (f32x4){0.f, 0.f, 0.f, 0.f};
    bf16x8 At[4][2], B0[2][2], B1[2][2];
    const char* cA = (const char*)g.A + (size_t)cur.pm * tstep; const char* cB = (const char*)g.Bt + (size_t)cur.pn * tstep;
    S.a_ready(cur);
    if constexpr (SP2) {
        PG8_STAGE(PG8_SB(0, 0), cB, voffB); PG8_STAGE(PG8_SB(0, 1), cB + hstep, voffB); PG8_STAGE(PG8_SA(0, 0), cA, voffA); PG8_STAGE(PG8_SA(0, 1), cA + hstep, voffA);
        if (wr == 1) PG8_BAR;
        PG8_WAIT_V(2); PG8_BAR;
        PG8_STAGE(PG8_SB(1, 0), cB + kstep, voffB); PG8_STAGE(PG8_SA(1, 0), cA + kstep, voffA); PG8_STAGE(PG8_SB(1, 1), cB + hstep + kstep, voffB);
        PG8_WAIT_V(6); PG8_BAR;
    } else {
        PG8_STAGE(PG8_SB(0, 0), cB, voffB); PG8_STAGE(PG8_SA(0, 0), cA, voffA); PG8_STAGE(PG8_SB(0, 1), cB + hstep, voffB); PG8_STAGE(PG8_SA(0, 1), cA + hstep, voffA);
        if (wr == 1) PG8_BAR;
        PG8_WAIT_V(4); PG8_BAR;
        PG8_STAGE(PG8_SB(1, 0), cB + kstep, voffB); PG8_STAGE(PG8_SA(1, 0), cA + kstep, voffA); PG8_STAGE(PG8_SB(1, 1), cB + hstep + kstep, voffB);
        PG8_WAIT_V(6); PG8_BAR;
    }
    for (;;) {
        const bool has_next = S.next(ui + 1, nxt);
        const char* nA = has_next ? (const char*)g.A + (size_t)nxt.pm * tstep : cA; const char* nB = has_next ? (const char*)g.Bt + (size_t)nxt.pn * tstep : cB;
        for (int t = 0; t < nt; t += 2) {
            const bool last = (t == nt - 2);
            const char* a1 = cA + (size_t)(t + 1) * kstep;
            const char* a2 = last ? nA : cA + (size_t)(t + 2) * kstep; const char* b2 = last ? nB : cB + (size_t)(t + 2) * kstep;
            const char* a3 = a2 + kstep; const char* b3 = b2 + kstep;
            if (last && has_next) S.a_ready(nxt);
            if constexpr (SP2) {
            PG8_LDB(B0, 0, 0); PG8_LDB(B1, 0, 1); PG8_SCHED; PG8_LDA(At, 0, 0); PG8_STAGE(PG8_SA(1, 1), a1 + hstep, voffA);
            PG8_WAIT_V(8); PG8_WAIT_L(0); PG8_BAR; PG8_MMA(0, 0, At, B0); PG8_MMA(0, 1, At, B1); PG8_BAR; PG8_SCHED;
            PG8_LDA(At, 0, 1); PG8_STAGE(PG8_SB(0, 0), b2, voffB); PG8_STAGE(PG8_SB(0, 1), b2 + hstep, voffB); PG8_STAGE(PG8_SA(0, 0), a2, voffA);
            PG8_WAIT_V(8); PG8_WAIT_L(0); PG8_BAR; PG8_MMA(1, 0, At, B0); PG8_MMA(1, 1, At, B1); PG8_BAR; PG8_SCHED;
            PG8_LDB(B0, 1, 0); PG8_LDB(B1, 1, 1); PG8_SCHED; PG8_LDA(At, 1, 0); PG8_STAGE(PG8_SA(0, 1), a2 + hstep, voffA);
            PG8_WAIT_V(8); PG8_WAIT_L(0); PG8_BAR; PG8_MMA(0, 0, At, B0); PG8_MMA(0, 1, At, B1); PG8_BAR; PG8_SCHED;
            PG8_LDA(At, 1, 1); PG8_STAGE(PG8_SB(1, 0), b3, voffB); PG8_STAGE(PG8_SB(1, 1), b3 + hstep, voffB); PG8_STAGE(PG8_SA(1, 0), a3, voffA);
            PG8_WAIT_V(8); PG8_WAIT_L(0); PG8_BAR; PG8_MMA(1, 0, At, B0); PG8_MMA(1, 1, At, B1); PG8_BAR; PG8_SCHED;
            } else {
            PG8_LDB(B0, 0, 0); PG8_SCHED; PG8_LDA(At, 0, 0); PG8_STAGE(PG8_SA(1, 1), a1 + hstep, voffA);
            PG8_WAIT_L(8); PG8_BAR; PG8_WAIT_L(0); PG8_MMA(0, 0, At, B0); PG8_BAR; PG8_SCHED;
            PG8_LDB(B1, 0, 1); PG8_STAGE(PG8_SB(0, 0), b2, voffB);
            PG8_BAR; PG8_WAIT_L(0); PG8_MMA(0, 1, At, B1); PG8_BAR;
            PG8_LDA(At, 0, 1); PG8_STAGE(PG8_SA(0, 0), a2, voffA);
            PG8_BAR; PG8_WAIT_L(0); PG8_MMA(1, 0, At, B0); PG8_BAR; PG8_SCHED;
            PG8_STAGE(PG8_SB(0, 1), b2 + hstep, voffB);
            PG8_WAIT_V(6); PG8_BAR; PG8_MMA(1, 1, At, B1); PG8_BAR;
            PG8_LDB(B0, 1, 0); PG8_SCHED; PG8_LDA(At, 1, 0); PG8_STAGE(PG8_SA(0, 1), a2 + hstep, voffA);
            PG8_WAIT_L(8); PG8_BAR; PG8_WAIT_L(0); PG8_MMA(0, 0, At, B0); PG8_BAR; PG8_SCHED;
            PG8_LDB(B1, 1, 1); PG8_STAGE(PG8_SB(1, 0), b3, voffB);
            PG8_BAR; PG8_WAIT_L(0); PG8_MMA(0, 1, At, B1); PG8_BAR;
            PG8_LDA(At, 1, 1); PG8_STAGE(PG8_SA(1, 0), a3, voffA);
            PG8_BAR; PG8_WAIT_L(0); PG8_MMA(1, 0, At, B0); PG8_BAR; PG8_SCHED;
            PG8_STAGE(PG8_SB(1, 1), b3 + hstep, voffB);
            PG8_WAIT_V(6); PG8_BAR; PG8_MMA(1, 1, At, B1); PG8_BAR;
            }
        }
        if constexpr (ALIGN_EPI) { if (wr == 0) PG8_BAR; }
        if constexpr (!Epi::AFTER_DRAIN) { E(acc, cur, wr, wc, fr, fq); S.done(cur); }
        if (!has_next) break;
#pragma unroll
        for (int a = 0; a < 2; ++a)
#pragma unroll
            for (int b = 0; b < 2; ++b)
#pragma unroll
                for (int m = 0; m < 4; ++m)
#pragma unroll
                    for (int n = 0; n < 2; ++n) acc[a][b][m][n] = (f32x4){0.f, 0.f, 0.f, 0.f};
        cur = nxt; cA = nA; cB = nB; ++ui;
        if constexpr (ALIGN_EPI) { if (wr == 1) PG8_BAR; }
    }
    PG8_WAIT_V(0);
    if constexpr (!ALIGN_EPI) { if (wr == 0) PG8_BAR; }
    PG8_BAR;
    if constexpr (Epi::AFTER_DRAIN) { E.fused(acc, cur, wr, wc, fr, fq, lds, wid, lane); S.done(cur); }
#undef PG8_SA
#undef PG8_SB
#undef PG8_STAGE
#undef PG8_LDA
#undef PG8_LDB
#undef PG8_MMA
#undef PG8_WAIT_V
#undef PG8_WAIT_L
#undef PG8_BAR
#undef PG8_SCHED
}
}

namespace pg8 {
struct EpiStore {
    static constexpr bool PERM = true, AFTER_DRAIN = false;
    bf16_t* O; int ldc;
    __device__ __forceinline__ void operator()(const f32x4 (&acc)[2][2][4][2], const Unit& u, int wr, int wc, int fr, int fq) const {
        const int row0 = u.pm * BM + wr * 64 + fr; const int col0 = u.pn * BM + wc * 32 + 8 * fq;
#pragma unroll
        for (int ai = 0; ai < 2; ++ai)
#pragma unroll
            for (int m = 0; m < 4; ++m) { bf16_t* rowp = O + (size_t)(row0 + ai * HALF + m * 16) * ldc + col0;
#pragma unroll
                for (int bj = 0; bj < 2; ++bj) { const f32x4 v0 = acc[ai][bj][m][0], v1 = acc[ai][bj][m][1];
                    u32x4 w; w.x = cvt_pk_bf16(v0[0], v0[1]); w.y = cvt_pk_bf16(v0[2], v0[3]); w.z = cvt_pk_bf16(v1[0], v1[1]); w.w = cvt_pk_bf16(v1[2], v1[3]);
                    *(u32x4*)(rowp + bj * HALF) = w; } }
    }
};
struct EpiSwiglu {
    static constexpr bool PERM = true, AFTER_DRAIN = false;
    bf16_t* O; int ldc;
    __device__ __forceinline__ void operator()(const f32x4 (&acc)[2][2][4][2], const Unit& u, int wr, int wc, int fr, int fq) const {
        const int row0 = u.pm * BM + wr * 64 + fr; const int col0 = u.pn * HALF + wc * 32 + 8 * fq;
#pragma unroll
        for (int ai = 0; ai < 2; ++ai)
#pragma unroll
            for (int m = 0; m < 4; ++m) { bf16_t* rowp = O + (size_t)(row0 + ai * HALF + m * 16) * ldc + col0;
                float h[8];
#pragma unroll
                for (int n = 0; n < 2; ++n)
#pragma unroll
                    for (int i = 0; i < 4; ++i) { const float g = acc[ai][0][m][n][i], up = acc[ai][1][m][n][i]; h[n * 4 + i] = g * __builtin_amdgcn_rcpf(1.f + __expf(-g)) * up; }
                u32x4 w; w.x = cvt_pk_bf16(h[0], h[1]); w.y = cvt_pk_bf16(h[2], h[3]); w.z = cvt_pk_bf16(h[4], h[5]); w.w = cvt_pk_bf16(h[6], h[7]);
                *(u32x4*)rowp = w; }
    }
};
}

using pg8::bf16_t; using pg8::bf16x8; using pg8::f32x4; using pg8::u32x4;
typedef float f32x16 __attribute__((ext_vector_type(16)));
typedef unsigned u32x2 __attribute__((ext_vector_type(2)));
#define DI __device__ __forceinline__
#define LDSFENCE() asm volatile("s_waitcnt lgkmcnt(0)" ::: "memory")
#define MFMA16(a, b, c) __builtin_amdgcn_mfma_f32_16x16x32_bf16((a), (b), (c), 0, 0, 0)
#define MFMA32(a, b, c) __builtin_amdgcn_mfma_f32_32x32x16_bf16((a), (b), (c), 0, 0, 0)

constexpr int DM = 1024, NB = 8, SL = 4096, NC = 256, TT = SL + NC, MR = NB * TT, DEPTH = 4;
constexpr int DIN = 2320, DINP = 2304, DFF = 2816;
constexpr int NCH = TT / 64, NCH32 = TT / 32;
constexpr int C_AQ = 0, C_AK = 512, C_AV = 640, C_MQ = 768, C_MK = 1024, C_MV = 1280, C_MO = 1536, C_RX = 1792, C_RY = 2048;
constexpr int MIX_ATT = 0, MIX_M = 512, MIX_R = 768;
constexpr float EPS = 1e-6f;
constexpr int NTHR = 512;
constexpr int RG = 5;
constexpr int LDS_BYTES = 147456;

constexpr size_t MiB = 1u << 20;
constexpr size_t WS_WIN = 0, WS_WOUT = 18 * MiB, WS_WF1 = 26 * MiB, WS_WF2 = 70 * MiB;
constexpr size_t WS_MOD = 92 * MiB, WS_ROPE = 93 * MiB, WS_LW = 93 * MiB + 512 * 1024, WS_GS = 94 * MiB, WS_MS = 94 * MiB + 256 * 1024, WS_M0 = 94 * MiB + 512 * 1024;
constexpr size_t WS_NLOC = 95 * MiB, WS_N0 = 97 * MiB, WS_LAGG = 99 * MiB, WS_CARRY = 104 * MiB, WS_GATES = 107 * MiB, WS_XC = 110 * MiB, WS_BAR = 119 * MiB;
constexpr size_t WS_ACT = 120 * MiB, WS_Y = 188 * MiB, WS_C0 = WS_Y, WS_CLOC = 256 * MiB, WS_P = 324 * MiB, WS_END = 511 * MiB;

struct Params {
    const float *x, *c, *ctx, *c_ctx, *w_ada, *b_ada, *norm_gain, *w_in, *w_out, *attn_sink, *mgate_b, *mnorm, *conv_w, *conv_b, *lru_w, *lru_b, *lru_lam, *w_f1, *w_f2;
    float* out; unsigned char* ws; int ph_lo, ph_hi;
};

DI float bf2f(unsigned short v) { return __uint_as_float((unsigned)v << 16); }
DI unsigned short f2bf(float f) { unsigned u = __float_as_uint(f); return (unsigned short)((u + 0x7fffu + ((u >> 16) & 1u)) >> 16); }
typedef __bf16 bf16x2_hw __attribute__((ext_vector_type(2)));
typedef float f32x2_hw __attribute__((ext_vector_type(2)));
DI unsigned pk2(float lo, float hi) { const f32x2_hw v = {lo, hi}; const bf16x2_hw b = __builtin_convertvector(v, bf16x2_hw); return __builtin_bit_cast(unsigned, b); }
DI void unpack8(const u32x4& v, float* f) {
    f[0] = __uint_as_float(v.x << 16); f[1] = __uint_as_float(v.x & 0xffff0000u); f[2] = __uint_as_float(v.y << 16); f[3] = __uint_as_float(v.y & 0xffff0000u);
    f[4] = __uint_as_float(v.z << 16); f[5] = __uint_as_float(v.z & 0xffff0000u); f[6] = __uint_as_float(v.w << 16); f[7] = __uint_as_float(v.w & 0xffff0000u);
}
DI u32x4 pack8(const float* f) { u32x4 w; w.x = pk2(f[0], f[1]); w.y = pk2(f[2], f[3]); w.z = pk2(f[4], f[5]); w.w = pk2(f[6], f[7]); return w; }
DI float wsum(float v) {
#pragma unroll
    for (int o = 32; o; o >>= 1) v += __shfl_xor(v, o);
    return v;
}
DI float wmaxf(float v) {
#pragma unroll
    for (int o = 32; o; o >>= 1) v = fmaxf(v, __shfl_xor(v, o));
    return v;
}
DI float frcp(float x) { return __builtin_amdgcn_rcpf(x); }
DI float sigmoidf_(float x) { return frcp(1.f + __expf(-x)); }
DI float logsigmoidf_(float x) { return fminf(x, 0.f) - log1pf(__expf(-fabsf(x))); }
DI float softplusf_(float x) { return fmaxf(x, 0.f) + log1pf(__expf(-fabsf(x))); }
DI float gelu_tanh(float y) { const float z = 0.7978845608028654f * (y + 0.044715f * y * y * y); const float th = 1.f - 2.f * frcp(__expf(2.f * z) + 1.f); return 0.5f * y * (1.f + th); }
DI float neg_expm1(float x) { const float pl = -x * (1.f + x * (0.5f + x * (0.16666667f + x * (0.041666668f + x * 0.008333334f)))); const float ex = 1.f - __expf(x); return x > -0.25f ? pl : ex; }
DI int crow(int reg, int h) { return (reg & 3) + 8 * (reg >> 2) + 4 * h; }

DI void transpose_tile(const float* src, int ldw, int k0, int srccol0, bf16_t* dst, int ldk, int dstrow0, float* tile) {
    int tid_l = threadIdx.x; asm volatile("" : "+v"(tid_l)); const int tid = tid_l;
    __syncthreads();
#pragma unroll
    for (int i = 0; i < 8; ++i) { const int kk = (tid >> 6) + 8 * i, nn = tid & 63; tile[kk * 65 + nn] = __builtin_nontemporal_load(&src[(size_t)(k0 + kk) * ldw + srccol0 + nn]); }
    __syncthreads();
    const int nn = tid >> 3, kg = tid & 7; float f[8];
#pragma unroll
    for (int j = 0; j < 8; ++j) f[j] = tile[(kg * 8 + j) * 65 + nn];
    *(u32x4*)(dst + (size_t)(dstrow0 + nn) * ldk + k0 + kg * 8) = pack8(f);
}

DI void convert_layer(const Params& p, unsigned char* lds, int l, int first, int nblk) {
    unsigned char* ws = p.ws; asm volatile("" : "+s"(ws));
    float* ldsf = (float*)lds;
    bf16_t* WIN = (bf16_t*)(ws + WS_WIN); bf16_t* WOUT = (bf16_t*)(ws + WS_WOUT); bf16_t* WF1 = (bf16_t*)(ws + WS_WF1); bf16_t* WF2 = (bf16_t*)(ws + WS_WF2);
    const int me = (int)blockIdx.x - first; if (me < 0) return;
    for (int it = me; it < 2944; it += nblk) {
        int rem = it;
        if (rem < 576) { const int kt = rem / 36, nt = rem % 36, dr = nt * 64, sc = dr < 1792 ? dr : dr + 16;
            transpose_tile(p.w_in + (size_t)l * 1024 * DIN, DIN, kt * 64, sc, WIN + (size_t)l * DINP * 1024, 1024, dr, ldsf); }
        else if (rem < 832) { rem -= 576; const int kt = rem / 16, nt = rem % 16;
            transpose_tile(p.w_out + (size_t)l * 1024 * 1024, 1024, kt * 64, nt * 64, WOUT + (size_t)l * 1024 * 1024, 1024, nt * 64, ldsf); }
        else if (rem < 2240) { rem -= 832; const int kt = rem / 88, nt = rem % 88, dr = nt * 64, tl = dr / 256, wi = dr % 256, sc = wi < 128 ? tl * 128 + wi : DFF + tl * 128 + wi - 128;
            transpose_tile(p.w_f1 + (size_t)l * 1024 * 2 * DFF, 2 * DFF, kt * 64, sc, WF1 + (size_t)l * 2 * DFF * 1024, 1024, dr, ldsf); }
        else { rem -= 2240; const int kt = rem / 16, nt = rem % 16;
            transpose_tile(p.w_f2 + (size_t)l * DFF * 1024, 1024, kt * 64, nt * 64, WF2 + (size_t)l * 1024 * DFF, DFF, nt * 64, ldsf); }
    }
}

DI void phase_setup(const Params& p, unsigned char* lds) {
    int tid_l = threadIdx.x; asm volatile("" : "+v"(tid_l)); const int tid = tid_l, G = gridDim.x, bid = blockIdx.x;
    unsigned char* ws = p.ws; asm volatile("" : "+s"(ws));
    float* ldsf = (float*)lds;
    {
        float* sl = ldsf;
        float* red = ldsf + 9 * 1024;
        for (int i = tid; i < 9 * 1024; i += NTHR) { const int bb = i >> 10, k = i & 1023; const float v = bb < 8 ? p.c[bb * 1024 + k] : p.c_ctx[k]; sl[i] = v / (1.f + __expf(-v)); }
        __syncthreads();
        float* MOD = (float*)(ws + WS_MOD);
        for (int it = bid; it < 4 * 192; it += G) {
            const int l = it / 192, n0 = (it % 192) * 32, cc = tid & 31, kg = tid >> 5;
            float acc[9];
#pragma unroll
            for (int bb = 0; bb < 9; ++bb) acc[bb] = 0.f;
            const float* wp = p.w_ada + ((size_t)l * 1024 + kg * 64) * 6144 + n0 + cc;
#pragma unroll 1
            for (int k0 = 0; k0 < 64; k0 += 16) { float w[16];
#pragma unroll
                for (int k = 0; k < 16; ++k) w[k] = __builtin_nontemporal_load(&wp[(size_t)(k0 + k) * 6144]);
#pragma unroll
                for (int k = 0; k < 16; ++k)
#pragma unroll
                    for (int bb = 0; bb < 9; ++bb) acc[bb] += sl[bb * 1024 + kg * 64 + k0 + k] * w[k]; }
#pragma unroll
            for (int bb = 0; bb < 9; ++bb) red[(kg * 9 + bb) * 32 + cc] = acc[bb];
            __syncthreads();
            if (tid < 288) { const int bb = tid >> 5; float s = p.b_ada[l * 6144 + n0 + cc];
                for (int q = 0; q < 16; ++q) s += red[(q * 9 + bb) * 32 + cc];
                MOD[((size_t)l * 9 + bb) * 6144 + n0 + cc] = s; }
            __syncthreads();
        }
    }
    convert_layer(p, lds, 0, 0, G);
    {
        bf16_t* LW = (bf16_t*)(ws + WS_LW);
        for (int m = bid; m < 64; m += G) transpose_tile(p.lru_w + (size_t)m * 4096, 64, 0, 0, LW + (size_t)m * 4096, 64, 0, ldsf);
    }
    if (bid == G - 1) {
        float* ROPE = (float*)(ws + WS_ROPE);
        for (int i = tid; i < 1024; i += NTHR) { const int pos = i >> 4, fi = i & 15; const float fr = exp2f(-(float)fi * (13.287712379549449f / 16.f)); const float ang = (float)pos * fr;
            const float n = rintf(ang * 0.15915494309189535f); float r = fmaf(-n, 6.28125f, ang); r = fmaf(-n, 1.9353071795864769e-3f, r);
            ROPE[2 * i] = cosf(r); ROPE[2 * i + 1] = sinf(r); }
    }
}

DI void phase_rows(const Params& p, unsigned char* lds, int l, int kind, float brs = 1.f) {
    int tid_l = threadIdx.x; asm volatile("" : "+v"(tid_l)); const int tid = tid_l, lane = tid & 63, wave = __builtin_amdgcn_readfirstlane(tid >> 6);
    unsigned char* ws = p.ws; asm volatile("" : "+s"(ws));
    const float* MOD = (const float*)(ws + WS_MOD);
    bf16_t* ACT = (bf16_t*)(ws + WS_ACT); const bf16_t* Y = (const bf16_t*)(ws + WS_Y); float* XC = (float*)(ws + WS_XC); float* GATES = (float*)(ws + WS_GATES);
    float* wgT = (float*)lds;
    const bool src_in = (l == 0 && kind <= 1);
    const bool has_br = !(kind == 0 && l == 0);
    const int lb = (kind == 0) ? l - 1 : l;
    const int gi_br = (kind == 1) ? 1 : 3, mi_br = (kind == 1) ? 2 : 5;
    const int gi_pre = (kind == 0) ? 0 : 2, mi_sh = (kind == 0) ? 0 : 3;
    __syncthreads();
    if (kind == 0) {
        const float* wsrc = p.w_in + (size_t)l * 1024 * DIN + 1792;
#pragma unroll 1
        for (int i0 = tid; i0 < 16384; i0 += 8 * NTHR) { float wv[8];
#pragma unroll
            for (int u = 0; u < 8; ++u) { const int i = i0 + u * NTHR; wv[u] = wsrc[(size_t)(i >> 4) * DIN + (i & 15)]; }
#pragma unroll
            for (int u = 0; u < 8; ++u) { const int i = i0 + u * NTHR; wgT[(i & 15) * 1028 + (i >> 4)] = wv[u]; } }
        __syncthreads();
    }
    const int wg = blockIdx.x * 8 + wave, nwv = gridDim.x * 8;
#pragma unroll 1
    for (int r0 = wg; r0 < MR; r0 += RG * nwv) {
        int rr_[RG]; bool ok[RG]; size_t xoff[RG]; bool isc[RG]; int bb[RG];
        float xv[RG][4][4]; u32x2 yraw[RG][4];
#pragma unroll
        for (int q = 0; q < RG; ++q) {
            int r = r0 + q * nwv; ok[q] = r < MR; if (!ok[q]) r = r0;
            const int b = r / TT, t = r - b * TT; isc[q] = t < NC; bb[q] = isc[q] ? 8 : b; rr_[q] = r;
            if ((kind == 2 || (kind == 1 && l == DEPTH - 1)) && isc[q]) ok[q] = false;
            xoff[q] = isc[q] ? ((size_t)b * NC + t) * DM : ((size_t)b * SL + (t - NC)) * DM;
            const float* xs = src_in ? (isc[q] ? p.ctx + xoff[q] : p.x + xoff[q]) : (isc[q] ? XC + xoff[q] : p.out + xoff[q]);
#pragma unroll
            for (int i = 0; i < 4; ++i) { const f32x4 v = __builtin_nontemporal_load((const f32x4*)(xs + 4 * lane + 256 * i)); xv[q][i][0] = v.x; xv[q][i][1] = v.y; xv[q][i][2] = v.z; xv[q][i][3] = v.w; }
            if (has_br) { const bf16_t* yr = Y + (size_t)r * DM;
#pragma unroll
                for (int i = 0; i < 4; ++i) yraw[q][i] = __builtin_nontemporal_load((const u32x2*)(yr + 4 * lane + 256 * i)); }
        }
#pragma unroll
        for (int q = 0; q < RG; ++q) {
            const int r = rr_[q];
            if (has_br) {
                float yv[4][4]; float ss = 0.f;
#pragma unroll
                for (int i = 0; i < 4; ++i) { const u32x2 v = yraw[q][i];
                    yv[i][0] = __uint_as_float(v.x << 16); yv[i][1] = __uint_as_float(v.x & 0xffff0000u); yv[i][2] = __uint_as_float(v.y << 16); yv[i][3] = __uint_as_float(v.y & 0xffff0000u);
#pragma unroll
                    for (int c = 0; c < 4; ++c) ss += yv[i][c] * yv[i][c]; }
                ss = wsum(ss); const float rs = brs * rsqrtf(ss * (1.f / 1024.f) + EPS);
                const float* gain = p.norm_gain + (size_t)(lb * 4 + gi_br) * 1024; const float* gate = MOD + ((size_t)(lb * 9 + bb[q]) * 6 + mi_br) * 1024;
                float* xd = isc[q] ? XC + xoff[q] : p.out + xoff[q];
#pragma unroll
                for (int i = 0; i < 4; ++i) { const float4 gv = *(const float4*)(gain + 4 * lane + 256 * i); const float4 mv = *(const float4*)(gate + 4 * lane + 256 * i);
                    xv[q][i][0] += mv.x * (yv[i][0] * rs * gv.x); xv[q][i][1] += mv.y * (yv[i][1] * rs * gv.y); xv[q][i][2] += mv.z * (yv[i][2] * rs * gv.z); xv[q][i][3] += mv.w * (yv[i][3] * rs * gv.w);
                    if (ok[q]) __builtin_nontemporal_store((f32x4){xv[q][i][0], xv[q][i][1], xv[q][i][2], xv[q][i][3]}, (f32x4*)(xd + 4 * lane + 256 * i)); }
            }
            if (kind != 2) {
                float ss = 0.f;
#pragma unroll
                for (int i = 0; i < 4; ++i)
#pragma unroll
                    for (int c = 0; c < 4; ++c) ss += xv[q][i][c] * xv[q][i][c];
                ss = wsum(ss); const float rs = rsqrtf(ss * (1.f / 1024.f) + EPS);
                const float* gain = p.norm_gain + (size_t)(l * 4 + gi_pre) * 1024; const float* sh = MOD + ((size_t)(l * 9 + bb[q]) * 6 + mi_sh) * 1024; const float* sc = sh + 1024;
                float hv[4][4];
#pragma unroll
                for (int i = 0; i < 4; ++i) { const float4 gv = *(const float4*)(gain + 4 * lane + 256 * i); const float4 sv = *(const float4*)(sh + 4 * lane + 256 * i); const float4 cv = *(const float4*)(sc + 4 * lane + 256 * i);
                    hv[i][0] = xv[q][i][0] * rs * gv.x * (1.f + cv.x) + sv.x; hv[i][1] = xv[q][i][1] * rs * gv.y * (1.f + cv.y) + sv.y; hv[i][2] = xv[q][i][2] * rs * gv.z * (1.f + cv.z) + sv.z; hv[i][3] = xv[q][i][3] * rs * gv.w * (1.f + cv.w) + sv.w;
                    u32x2 o; o.x = pk2(hv[i][0], hv[i][1]); o.y = pk2(hv[i][2], hv[i][3]); if (ok[q]) *(u32x2*)(ACT + (size_t)r * DM + 4 * lane + 256 * i) = o; }
                if (kind == 0) {
#pragma unroll
                    for (int i = 0; i < 4; ++i)
#pragma unroll
                        for (int c = 0; c < 4; ++c) xv[q][i][c] = hv[i][c];
                }
            }
        }
        if (kind == 0) {
#pragma unroll 1
            for (int j0 = 0; j0 < 4; ++j0) {
                float a[RG][4];
#pragma unroll
                for (int q = 0; q < RG; ++q)
#pragma unroll
                    for (int jj = 0; jj < 4; ++jj) a[q][jj] = 0.f;
#pragma unroll
                for (int jj = 0; jj < 4; ++jj)
#pragma unroll
                    for (int i = 0; i < 4; ++i) { const float4 w = *(const float4*)(wgT + (4 * j0 + jj) * 1028 + 4 * lane + 256 * i);
#pragma unroll
                        for (int q = 0; q < RG; ++q) a[q][jj] += xv[q][i][0] * w.x + xv[q][i][1] * w.y + xv[q][i][2] * w.z + xv[q][i][3] * w.w; }
#pragma unroll
                for (int q = 0; q < RG; ++q) {
                    { const bool hi = (lane & 32) != 0;
#pragma unroll
                      for (int i = 0; i < 2; ++i) { const float send = hi ? a[q][i] : a[q][i + 2], keep = hi ? a[q][i + 2] : a[q][i]; a[q][i] = keep + __shfl_xor(send, 32); } }
                    { const bool hi = (lane & 16) != 0; const float send = hi ? a[q][0] : a[q][1], keep = hi ? a[q][1] : a[q][0]; a[q][0] = keep + __shfl_xor(send, 16); }
                    a[q][0] += __shfl_xor(a[q][0], 8); a[q][0] += __shfl_xor(a[q][0], 4); a[q][0] += __shfl_xor(a[q][0], 2); a[q][0] += __shfl_xor(a[q][0], 1);
                    if (ok[q] && (lane & 15) == 0) GATES[(size_t)rr_[q] * 16 + 4 * j0 + (lane >> 4)] = a[q][0];
                }
            }
        }
    }
}

DI void attn_unit(const Params& p, unsigned char* lds, int l, int b, int qb64, int kvh, bool isctx) {
    int tid_l = threadIdx.x; asm volatile("" : "+v"(tid_l)); const int tid = tid_l, lane = tid & 63, wave = __builtin_amdgcn_readfirstlane(tid >> 6);
    const int g = wave >> 1, half = wave & 1, head = kvh * 4 + g, hh = lane >> 5, ql = lane & 31;
    unsigned char* ws = p.ws; asm volatile("" : "+s"(ws));
    const bf16_t* P = (const bf16_t*)(ws + WS_P); bf16_t* MIX = (bf16_t*)(ws + WS_ACT); const float* rope = (const float*)(ws + WS_ROPE);
    bf16_t* Ks = (bf16_t*)lds;
    bf16_t* Vt = (bf16_t*)(lds + 18432);
    const size_t rowb = (size_t)b * TT;
    const int qpos = qb64 * 64 + half * 32 + ql;
    const int tq = (isctx ? 0 : NC) + qpos;
    const int kb0 = qb64 >> 1;
    constexpr float LOG2E = 1.4426950408889634f;
    bf16x8 qf[4];
    {
        const bf16_t* qp = P + (rowb + tq) * DINP + C_AQ + head * 64 + 8 * hh;
        float f[4][8];
#pragma unroll
        for (int kk = 0; kk < 4; ++kk) { const u32x4 raw = __builtin_nontemporal_load((const u32x4*)(qp + 16 * kk)); unpack8(raw, f[kk]); }
        if (!isctx) { const int rr = qpos >> 6, cc = qpos & 63;
#pragma unroll
            for (int j = 0; j < 8; ++j) { const int i = 8 * hh + j; const float2 r1 = *(const float2*)(rope + (rr * 16 + i) * 2), r2 = *(const float2*)(rope + (cc * 16 + i) * 2);
                float x1 = f[0][j], x2 = f[1][j]; f[0][j] = x1 * r1.x - x2 * r1.y; f[1][j] = x2 * r1.x + x1 * r1.y;
                x1 = f[2][j]; x2 = f[3][j]; f[2][j] = x1 * r2.x - x2 * r2.y; f[3][j] = x2 * r2.x + x1 * r2.y; } }
#pragma unroll
        for (int kk = 0; kk < 4; ++kk) {
#pragma unroll
            for (int j = 0; j < 8; ++j) f[kk][j] *= 0.125f * LOG2E;
            qf[kk] = __builtin_bit_cast(bf16x8, pack8(f[kk])); }
    }
    const float sink = p.attn_sink[l * 8 + head] * LOG2E;
    float mrun = sink, lsum = hh == 0 ? 1.f : 0.f;
    f32x16 O[2];
#pragma unroll
    for (int c = 0; c < 2; ++c)
#pragma unroll
        for (int i = 0; i < 16; ++i) O[c][i] = 0.f;

    const int skey = tid >> 2, spart = tid & 3, sc = (spart & 1) + (spart >> 1) * 4;
    u32x4 pra, prb, pv0, pv1;
    int ti = 0;
#define ATT_TILE_ROW(ti_) ((ti_) < 2 ? (ti_) * 128 : NC + (kb0 + (ti_) - 3) * 128)
#define ATT_LOAD(ti_) do { const bf16_t* kp_ = P + (rowb + ATT_TILE_ROW(ti_) + skey) * DINP + C_AK + kvh * 64; pra = *(const u32x4*)(kp_ + 8 * sc); prb = *(const u32x4*)(kp_ + 8 * (sc + 2)); \
        const bf16_t* vp_ = P + (rowb + ATT_TILE_ROW(ti_) + skey) * DINP + C_AV + kvh * 64 + spart * 16; pv0 = *(const u32x4*)vp_; pv1 = *(const u32x4*)(vp_ + 8); } while (0)
    ATT_LOAD(0);
#pragma unroll 1
    while (ti < 5) {
        const bool kctx = ti < 2; const int kb = kb0 + ti - 3; const int kt0 = ATT_TILE_ROW(ti);
        int tn = ti + 1;
        if (isctx) { if (tn >= 2) tn = 5; } else { if (tn == 2 && kb0 == 0) tn = 3; if (tn == 4 && kb0 == 31) tn = 5; }
        __syncthreads();
        {
            u32x4 ra = pra, rb = prb;
            if (!kctx) { float fa[8], fb[8]; unpack8(ra, fa); unpack8(rb, fb); const int pos = kt0 - NC + skey, tp = sc < 2 ? pos >> 6 : pos & 63, ib = 8 * (sc & 1);
#pragma unroll
                for (int j = 0; j < 8; ++j) { const float2 cs = *(const float2*)(rope + (tp * 16 + ib + j) * 2); const float x1 = fa[j], x2 = fb[j]; fa[j] = x1 * cs.x - x2 * cs.y; fb[j] = x2 * cs.x + x1 * cs.y; }
                ra = pack8(fa); rb = pack8(fb); }
            *(u32x4*)(Ks + skey * 72 + 8 * sc) = ra; *(u32x4*)(Ks + skey * 72 + 8 * (sc + 2)) = rb;
            const unsigned vv[8] = {pv0.x, pv0.y, pv0.z, pv0.w, pv1.x, pv1.y, pv1.z, pv1.w};
#pragma unroll
            for (int e = 0; e < 8; ++e) { Vt[(spart * 16 + 2 * e) * 136 + skey] = (bf16_t)(vv[e] & 0xffffu); Vt[(spart * 16 + 2 * e + 1) * 136 + skey] = (bf16_t)(vv[e] >> 16); }
        }
        if (tn < 5) ATT_LOAD(tn);
        __syncthreads();
        const bool domask = (!kctx) && (ti != 3);
        int k2lo = 0, k2hi = 2;
        if (!kctx) { if (ti == 2 && (qb64 & 1)) k2lo = 1; if (ti == 4 && !(qb64 & 1)) k2hi = 1; }
#pragma unroll 1
        for (int k2 = k2lo; k2 < k2hi; ++k2) {
            f32x16 s[2];
#pragma unroll
            for (int ks = 0; ks < 2; ++ks) {
#pragma unroll
                for (int i = 0; i < 16; ++i) s[ks][i] = 0.f;
#pragma unroll
                for (int kk = 0; kk < 4; ++kk) { const bf16x8 ka = *(const bf16x8*)(Ks + (64 * k2 + 32 * ks + ql) * 72 + 16 * kk + 8 * hh); s[ks] = MFMA32(ka, qf[kk], s[ks]); }
            }
            if (domask) {
#pragma unroll
                for (int ks = 0; ks < 2; ++ks)
#pragma unroll
                    for (int i = 0; i < 16; ++i) { const int kpos = kb * 128 + 64 * k2 + 32 * ks + crow(i, hh); const int dd = qpos - kpos; if (dd > 128 || dd < -128) s[ks][i] = -INFINITY; } }
            float tmax = fmaxf(s[0][0], s[1][0]);
#pragma unroll
            for (int i = 1; i < 16; ++i) tmax = fmaxf(tmax, fmaxf(s[0][i], s[1][i]));
            tmax = fmaxf(tmax, __shfl_xor(tmax, 32));
            const float mnew = fmaxf(mrun, tmax), alpha = __builtin_amdgcn_exp2f(mrun - mnew); mrun = mnew;
            float psum = 0.f;
#pragma unroll
            for (int ks = 0; ks < 2; ++ks)
#pragma unroll
                for (int i = 0; i < 16; ++i) { s[ks][i] = __builtin_amdgcn_exp2f(s[ks][i] - mnew); psum += s[ks][i]; }
            lsum = lsum * alpha + psum;
#pragma unroll
            for (int dt = 0; dt < 2; ++dt)
#pragma unroll
                for (int i = 0; i < 16; ++i) O[dt][i] *= alpha;
#pragma unroll
            for (int ks = 0; ks < 2; ++ks)
#pragma unroll
                for (int st = 0; st < 2; ++st) {
                    u32x4 pw; pw.x = pk2(s[ks][8 * st], s[ks][8 * st + 1]); pw.y = pk2(s[ks][8 * st + 2], s[ks][8 * st + 3]); pw.z = pk2(s[ks][8 * st + 4], s[ks][8 * st + 5]); pw.w = pk2(s[ks][8 * st + 6], s[ks][8 * st + 7]);
                    const bf16x8 pb = __builtin_bit_cast(bf16x8, pw);
#pragma unroll
                    for (int dt = 0; dt < 2; ++dt) { const bf16_t* vr = Vt + (32 * dt + ql) * 136 + 64 * k2 + 32 * ks + 16 * st + 4 * hh;
                        const u32x2 a0 = *(const u32x2*)vr, a1 = *(const u32x2*)(vr + 8); u32x4 aw; aw.x = a0.x; aw.y = a0.y; aw.z = a1.x; aw.w = a1.y;
                        O[dt] = MFMA32(__builtin_bit_cast(bf16x8, aw), pb, O[dt]); }
                }
        }
        ti = tn;
    }
#undef ATT_LOAD
#undef ATT_TILE_ROW
    {
        const float ltot = lsum + __shfl_xor(lsum, 32), inv = frcp(ltot);
        bf16_t* op = MIX + (rowb + tq) * DM + MIX_ATT + head * 64;
#pragma unroll
        for (int dt = 0; dt < 2; ++dt)
#pragma unroll
            for (int g4 = 0; g4 < 4; ++g4) { u32x2 o; o.x = pk2(O[dt][4 * g4] * inv, O[dt][4 * g4 + 1] * inv); o.y = pk2(O[dt][4 * g4 + 2] * inv, O[dt][4 * g4 + 3] * inv);
                *(u32x2*)(op + 32 * dt + 8 * g4 + 4 * hh) = o; }
    }
}

DI void stage_rows(const bf16_t* src, bf16_t* dst) {
    int tid_l = threadIdx.x; asm volatile("" : "+v"(tid_l)); const int tid = tid_l;
#pragma unroll
    for (int it = 0; it < 4; ++it) { const int idx = tid + it * NTHR, t = idx >> 5, cg = idx & 31; *(u32x4*)(dst + t * 264 + 8 * cg) = *(const u32x4*)(src + (size_t)t * DINP + 8 * cg); }
}
DI void stage_transposed(const bf16_t* src, bf16_t* dst) {
    int tid_l = threadIdx.x; asm volatile("" : "+v"(tid_l)); const int tid = tid_l;
#pragma unroll
    for (int it = 0; it < 4; ++it) { const int idx = tid + it * NTHR, t = idx & 63, cg = idx >> 6; const u32x4 v = *(const u32x4*)(src + (size_t)t * DINP + 8 * cg);
        const unsigned vv[4] = {v.x, v.y, v.z, v.w};
#pragma unroll
        for (int e = 0; e < 4; ++e) { dst[(8 * cg + 2 * e) * 72 + t] = (bf16_t)(vv[e] & 0xffffu); dst[(8 * cg + 2 * e + 1) * 72 + t] = (bf16_t)(vv[e] >> 16); } }
#pragma unroll
    for (int it = 0; it < 2; ++it) { const int idx = tid + it * NTHR; dst[(256 + (idx >> 6)) * 72 + (idx & 63)] = (bf16_t)0x3F80; }
}
DI float prefix_sum(float v, int lane) {
#pragma unroll
    for (int o = 1; o < 64; o <<= 1) { const float u = __shfl_up(v, o); if (lane >= o) v += u; }
    return v;
}
DI float prefix_max(float v, int lane) {
#pragma unroll
    for (int o = 1; o < 64; o <<= 1) { const float u = __shfl_up(v, o); if (lane >= o) v = fmaxf(v, u); }
    return v;
}

DI void mlstm_local_unit(const Params& p, unsigned char* lds, int l, int b, int c) {
    int tid_l = threadIdx.x; asm volatile("" : "+v"(tid_l)); const int tid = tid_l, lane = tid & 63, wave = __builtin_amdgcn_readfirstlane(tid >> 6), h = wave & 3, d = wave >> 2, fr = lane & 15, fq = lane >> 4;
    unsigned char* ws = p.ws; asm volatile("" : "+s"(ws));
    const bf16_t* P = (const bf16_t*)(ws + WS_P); const float* GATES = (const float*)(ws + WS_GATES);
    float* GS = (float*)(ws + WS_GS); float* MS = (float*)(ws + WS_MS); float* CLOC = (float*)(ws + WS_CLOC); float* NLOC = (float*)(ws + WS_NLOC);
    bf16_t* Kt = (bf16_t*)lds;
    bf16_t* Vt = (bf16_t*)(lds + 36864);
    float* wl = (float*)(lds + 76032) + wave * 64;
    const size_t row0 = (size_t)b * TT + c * 64;
    __syncthreads();
    stage_transposed(P + row0 * DINP + C_MK, Kt);
    stage_transposed(P + row0 * DINP + C_MV, Vt);
    const int tau = d ? 63 - lane : lane;
    const float* G = GATES + (row0 + tau) * 16; const float* gb = p.mgate_b + l * 16;
    const float li = G[(2 * d) * 4 + h] + gb[(2 * d) * 4 + h]; const float lf = logsigmoidf_(G[(2 * d + 1) * 4 + h] + gb[(2 * d + 1) * 4 + h]);
    const float bc = prefix_sum(lf, lane); const float gt = __shfl(bc, 63); const float a = gt - bc + li; const float ml = wmaxf(a); const float w = __expf(a - ml);
    wl[tau] = w;
    const int nd = d ? (c < 4 ? 3 - c : 71 - c) : c; const int sid = (b * 4 + h) * 2 + d;
    if (lane == 0) { GS[sid * NCH + nd] = gt; MS[sid * NCH + nd] = ml; }
    __syncthreads();
    bf16x8 va[4][2];
#pragma unroll
    for (int et = 0; et < 4; ++et)
#pragma unroll
        for (int kk = 0; kk < 2; ++kk) va[et][kk] = *(const bf16x8*)(Vt + (h * 64 + 16 * et + fr) * 72 + 32 * kk + 8 * fq);
    float* outp = CLOC + ((size_t)sid * NCH + nd) * 4096;
#pragma unroll
    for (int dt = 0; dt < 4; ++dt) {
        bf16x8 kb[2];
#pragma unroll
        for (int kk = 0; kk < 2; ++kk) { const u32x4 raw = *(const u32x4*)(Kt + (h * 64 + 16 * dt + fr) * 72 + 32 * kk + 8 * fq); float f[8]; unpack8(raw, f);
            const float4 w0 = *(const float4*)(wl + 32 * kk + 8 * fq), w1 = *(const float4*)(wl + 32 * kk + 8 * fq + 4);
            f[0] *= w0.x; f[1] *= w0.y; f[2] *= w0.z; f[3] *= w0.w; f[4] *= w1.x; f[5] *= w1.y; f[6] *= w1.z; f[7] *= w1.w;
            kb[kk] = __builtin_bit_cast(bf16x8, pack8(f)); }
#pragma unroll
        for (int et = 0; et < 4; ++et) { f32x4 acc = {0.f, 0.f, 0.f, 0.f};
#pragma unroll
            for (int kk = 0; kk < 2; ++kk) acc = MFMA16(va[et][kk], kb[kk], acc);
#pragma unroll
            for (int j = 0; j < 4; ++j) __builtin_nontemporal_store(acc[j] * 0.125f, &outp[(16 * et + 4 * fq + j) * 64 + 16 * dt + fr]); }
    }
    { float s = 0.f; const bf16_t* kr = Kt + (h * 64 + lane) * 72;
#pragma unroll
      for (int t8 = 0; t8 < 8; ++t8) { const u32x4 raw = *(const u32x4*)(kr + 8 * t8); float f[8]; unpack8(raw, f);
#pragma unroll
          for (int j = 0; j < 8; ++j) s += f[j] * wl[8 * t8 + j]; }
      NLOC[((size_t)sid * NCH + nd) * 64 + lane] = s * 0.125f; }
}

DI void mlstm_scan_unit(const Params& p, unsigned char* lds, int u) {
    int tid_l = threadIdx.x; asm volatile("" : "+v"(tid_l)); const int tid = tid_l, sid = u >> 3, slab = u & 7;
    unsigned char* ws = p.ws; asm volatile("" : "+s"(ws));
    const float* GS = (const float*)(ws + WS_GS); const float* MS = (const float*)(ws + WS_MS); float* M0 = (float*)(ws + WS_M0);
    const float* CLOC = (const float*)(ws + WS_CLOC); bf16_t* C0 = (bf16_t*)(ws + WS_C0); const float* NLOC = (const float*)(ws + WS_NLOC); float* N0 = (float*)(ws + WS_N0);
    float* fpv = (float*)lds; float* flv = fpv + 128;
    __syncthreads();
    float* gsv = fpv + 256; float* msv = fpv + 384; float* m0v = fpv + 512;
    if (tid < NCH) { gsv[tid] = GS[sid * NCH + tid]; msv[tid] = MS[sid * NCH + tid]; }
    __syncthreads();
    if (tid == 0) { float m = 0.f;
        for (int j = 0; j < NCH; ++j) { const float g = gsv[j], ml = msv[j]; const float mn = fmaxf(g + m, ml); fpv[j] = __expf(g + m - mn); flv[j] = __expf(ml - mn); m0v[j] = m; m = mn; } }
    __syncthreads();
    if (slab == 0 && tid < NCH) M0[sid * NCH + tid] = m0v[tid];
    { const float* src = CLOC + (size_t)sid * NCH * 4096 + slab * 512 + tid; bf16_t* dst = C0 + (size_t)sid * NCH * 4096 + slab * 512 + tid; float C = 0.f;
#pragma unroll 1
      for (int j0 = 0; j0 < NCH; j0 += 17) { float v[17];
#pragma unroll
          for (int k = 0; k < 17; ++k) v[k] = __builtin_nontemporal_load(&src[(size_t)(j0 + k) * 4096]);
#pragma unroll
          for (int k = 0; k < 17; ++k) { dst[(size_t)(j0 + k) * 4096] = f2bf(C); C = fpv[j0 + k] * C + flv[j0 + k] * v[k]; } } }
    if (slab == 0 && tid < 64) { const float* src = NLOC + (size_t)sid * NCH * 64 + tid; float* dst = N0 + (size_t)sid * NCH * 64 + tid; float C = 0.f;
        for (int j = 0; j < NCH; ++j) { const float v = src[j * 64]; dst[j * 64] = C; C = fpv[j] * C + flv[j] * v; } }
}

DI void mlstm_out_unit(const Params& p, unsigned char* lds, int l, int b, int c) {
    int tid_l = threadIdx.x; asm volatile("" : "+v"(tid_l)); const int tid = tid_l, lane = tid & 63, wave = __builtin_amdgcn_readfirstlane(tid >> 6), h = wave & 3, d = wave >> 2, fr = lane & 15, fq = lane >> 4;
    unsigned char* ws = p.ws; asm volatile("" : "+s"(ws));
    const bf16_t* P = (const bf16_t*)(ws + WS_P); bf16_t* MIX = (bf16_t*)(ws + WS_ACT); const float* GATES = (const float*)(ws + WS_GATES);
    const float* M0 = (const float*)(ws + WS_M0); const bf16_t* C0 = (const bf16_t*)(ws + WS_C0); const float* N0 = (const float*)(ws + WS_N0);
    bf16_t* Vt = (bf16_t*)lds;
    bf16_t* Sp = (bf16_t*)(lds + 39168) + wave * 1152;
    float* scal = (float*)(lds + 57600) + wave * 192;
    float* hbuf = (float*)(lds + 63744);
    const size_t row0 = (size_t)b * TT + c * 64;
    __syncthreads();
    stage_transposed(P + row0 * DINP + C_MV, Vt);
    for (int i = tid; i < 64 * 260; i += NTHR) hbuf[i] = 0.f;
    const int tau = d ? 63 - lane : lane;
    const float* G = GATES + (row0 + tau) * 16; const float* gb = p.mgate_b + l * 16;
    const float li = G[(2 * d) * 4 + h] + gb[(2 * d) * 4 + h]; const float lf = logsigmoidf_(G[(2 * d + 1) * 4 + h] + gb[(2 * d + 1) * 4 + h]);
    const float bc = prefix_sum(lf, lane); const float cs = li - bc; const float mx = prefix_max(cs, lane);
    const int nd = d ? (c < 4 ? 3 - c : 71 - c) : c; const int sid = (b * 4 + h) * 2 + d;
    const float m0 = M0[sid * NCH + nd]; const float mu = fmaxf(mx, m0);
    scal[tau] = cs; scal[64 + tau] = mu; scal[128 + tau] = bc;
    __syncthreads();
    const bf16_t* C0p = C0 + ((size_t)sid * NCH + nd) * 4096; const float* N0p = N0 + ((size_t)sid * NCH + nd) * 64;
    const bf16_t* Qg = P + row0 * DINP + C_MQ + h * 64 + 8 * fq; const bf16_t* Kg = P + row0 * DINP + C_MK + h * 64 + 8 * fq;
    bf16x8 kf[4][2], nf[2], qall[4][2], cfr[4][2];
#pragma unroll
    for (int kk = 0; kk < 2; ++kk) {
#pragma unroll
        for (int ns = 0; ns < 4; ++ns) { kf[ns][kk] = *(const bf16x8*)(Kg + (size_t)(16 * ns + fr) * DINP + 32 * kk); qall[ns][kk] = *(const bf16x8*)(Qg + (size_t)(16 * ns + fr) * DINP + 32 * kk);
            cfr[ns][kk] = *(const bf16x8*)(C0p + (16 * ns + fr) * 64 + 32 * kk + 8 * fq); }
        float f[8];
#pragma unroll
        for (int j = 0; j < 8; ++j) f[j] = N0p[32 * kk + 8 * fq + j];
        nf[kk] = __builtin_bit_cast(bf16x8, pack8(f));
    }
#pragma unroll
    for (int mt = 0; mt < 4; ++mt) {
        bf16x8 qa[2];
#pragma unroll
        for (int kk = 0; kk < 2; ++kk) qa[kk] = qall[mt][kk];
#pragma unroll
        for (int ns = 0; ns < 4; ++ns) { f32x4 s = {0.f, 0.f, 0.f, 0.f};
#pragma unroll
            for (int kk = 0; kk < 2; ++kk) s = MFMA16(qa[kk], kf[ns][kk], s);
            const int sx = 16 * ns + fr; const float csx = scal[sx];
#pragma unroll
            for (int j = 0; j < 4; ++j) { const int t = 16 * mt + 4 * fq + j; const bool ok = d ? (sx >= t) : (sx <= t); const float val = ok ? s[j] * 0.125f * __expf(csx - scal[64 + t]) : 0.f; Sp[(4 * fq + j) * 72 + sx] = f2bf(val); } }
        LDSFENCE();
        f32x4 aS[5], aI[5];
#pragma unroll
        for (int et = 0; et < 5; ++et) { aS[et] = (f32x4){0.f, 0.f, 0.f, 0.f}; aI[et] = (f32x4){0.f, 0.f, 0.f, 0.f}; }
#pragma unroll
        for (int kk = 0; kk < 2; ++kk) { const bf16x8 sa = *(const bf16x8*)(Sp + fr * 72 + 32 * kk + 8 * fq);
#pragma unroll
            for (int et = 0; et < 5; ++et) { const bf16x8 vf = *(const bf16x8*)(Vt + ((et < 4 ? h * 64 + 16 * et : 256) + fr) * 72 + 32 * kk + 8 * fq); aS[et] = MFMA16(sa, vf, aS[et]); }
#pragma unroll
            for (int et = 0; et < 4; ++et) aI[et] = MFMA16(qa[kk], cfr[et][kk], aI[et]);
            aI[4] = MFMA16(qa[kk], nf[kk], aI[4]); }
#pragma unroll
        for (int j = 0; j < 4; ++j) { const int t = 16 * mt + 4 * fq + j; const float mut = scal[64 + t]; const float fi = __expf(m0 - mut); const float den = fi * aI[4][j] + aS[4][j];
            const float lim = __expf(-scal[128 + t] - mut); const float inv = frcp(fmaxf(fabsf(den), lim));
#pragma unroll
            for (int et = 0; et < 4; ++et) atomicAdd(&hbuf[t * 260 + h * 64 + 16 * et + fr], (fi * aI[et][j] + aS[et][j]) * inv); }
        LDSFENCE();
    }
    __syncthreads();
    float ng[4];
#pragma unroll
    for (int h2 = 0; h2 < 4; ++h2) ng[h2] = p.mnorm[l * 256 + h2 * 64 + lane];
#pragma unroll 1
    for (int kb = 0; kb < 32; kb += 8) {
        float ov[8];
#pragma unroll
        for (int k = 0; k < 8; ++k) { const int t = wave * 8 + ((kb + k) >> 2), h2 = k & 3; ov[k] = bf2f(P[(row0 + t) * DINP + C_MO + h2 * 64 + lane]); }
#pragma unroll
        for (int k = 0; k < 8; ++k) { const int t = wave * 8 + ((kb + k) >> 2), h2 = k & 3; const float v = hbuf[t * 260 + h2 * 64 + lane];
            float s1 = v, s2 = v * v;
#pragma unroll
            for (int o = 32; o; o >>= 1) { s1 += __shfl_xor(s1, o); s2 += __shfl_xor(s2, o); }
            const float mean = s1 * (1.f / 64.f); const float var = fmaxf(s2 * (1.f / 64.f) - mean * mean, 0.f);
            const float y = (v - mean) * rsqrtf(var + EPS) * ng[h2];
            MIX[(row0 + t) * DM + MIX_M + h2 * 64 + lane] = f2bf(y * sigmoidf_(ov[k])); }
    }
}

DI void mlstm_out_wave_unit(const Params& p, unsigned char* ldsw, int l, int b, int c, int h, int lane) {
    asm volatile("" : "+v"(lane));
    const int fr = lane & 15, fq = lane >> 4;
    unsigned char* ws = p.ws; asm volatile("" : "+s"(ws));
    const bf16_t* P = (const bf16_t*)(ws + WS_P); bf16_t* MIX = (bf16_t*)(ws + WS_ACT); const float* GATES = (const float*)(ws + WS_GATES);
    const float* M0 = (const float*)(ws + WS_M0); const bf16_t* C0 = (const bf16_t*)(ws + WS_C0); const float* N0 = (const float*)(ws + WS_N0);
    bf16_t* Vt = (bf16_t*)ldsw;
    bf16_t* Sp = (bf16_t*)(ldsw + 11520);
    float* scal = (float*)(ldsw + 13824);
    bf16_t* Ot = (bf16_t*)(ldsw + 15360);
    const size_t row0 = (size_t)b * TT + c * 64;
    LDSFENCE();
#pragma unroll
    for (int cg = 0; cg < 8; ++cg) { const u32x4 v = *(const u32x4*)(P + (row0 + lane) * DINP + C_MV + h * 64 + 8 * cg); const unsigned vv[4] = {v.x, v.y, v.z, v.w};
#pragma unroll
        for (int e = 0; e < 4; ++e) { Vt[(8 * cg + 2 * e) * 72 + lane] = (bf16_t)(vv[e] & 0xffffu); Vt[(8 * cg + 2 * e + 1) * 72 + lane] = (bf16_t)(vv[e] >> 16); } }
#pragma unroll
    for (int i = 0; i < 16; ++i) Vt[(64 + i) * 72 + lane] = (bf16_t)0x3F80;
    const bf16_t* Qg = P + row0 * DINP + C_MQ + h * 64 + 8 * fq; const bf16_t* Kg = P + row0 * DINP + C_MK + h * 64 + 8 * fq;
    bf16x8 kf[4][2];
#pragma unroll
    for (int kk = 0; kk < 2; ++kk)
#pragma unroll
        for (int ns = 0; ns < 4; ++ns) kf[ns][kk] = *(const bf16x8*)(Kg + (size_t)(16 * ns + fr) * DINP + 32 * kk);
    const float* gb = p.mgate_b + l * 16;
    float m0d[2]; const bf16_t* C0d[2]; bf16x8 nf[2][2];
#pragma unroll
    for (int d = 0; d < 2; ++d) {
        const int tau = d ? 63 - lane : lane;
        const float* G = GATES + (row0 + tau) * 16;
        const float li = G[(2 * d) * 4 + h] + gb[(2 * d) * 4 + h]; const float lf = logsigmoidf_(G[(2 * d + 1) * 4 + h] + gb[(2 * d + 1) * 4 + h]);
        const float bc = prefix_sum(lf, lane); const float cs = li - bc; const float mx = prefix_max(cs, lane);
        const int nd = d ? (c < 4 ? 3 - c : 71 - c) : c; const int sid = (b * 4 + h) * 2 + d;
        const float m0 = M0[sid * NCH + nd]; const float mu = fmaxf(mx, m0);
        m0d[d] = m0; C0d[d] = C0 + ((size_t)sid * NCH + nd) * 4096 + fr * 64 + 8 * fq;
        scal[d * 192 + tau] = cs; scal[d * 192 + 64 + tau] = mu; scal[d * 192 + 128 + tau] = bc;
        const float* N0p = N0 + ((size_t)sid * NCH + nd) * 64;
#pragma unroll
        for (int kk = 0; kk < 2; ++kk) { float f[8];
#pragma unroll
            for (int j = 0; j < 8; ++j) f[j] = N0p[32 * kk + 8 * fq + j];
            nf[d][kk] = __builtin_bit_cast(bf16x8, pack8(f)); }
    }
    float ng[4];
#pragma unroll
    for (int et = 0; et < 4; ++et) ng[et] = p.mnorm[l * 256 + h * 64 + 16 * et + fr];
    LDSFENCE();
#pragma unroll 1
    for (int mt = 0; mt < 4; ++mt) {
        bf16x8 qa[2];
#pragma unroll
        for (int kk = 0; kk < 2; ++kk) qa[kk] = *(const bf16x8*)(Qg + (size_t)(16 * mt + fr) * DINP + 32 * kk);
#pragma unroll
        for (int i = 0; i < 2; ++i) { const int idx = lane + 64 * i, tl = idx >> 3, cg = idx & 7; *(u32x4*)(Ot + tl * 72 + 8 * cg) = __builtin_nontemporal_load((const u32x4*)(P + (row0 + 16 * mt + tl) * DINP + C_MO + h * 64 + 8 * cg)); }
        f32x4 hacc[4];
#pragma unroll
        for (int et = 0; et < 4; ++et) hacc[et] = (f32x4){0.f, 0.f, 0.f, 0.f};
#pragma unroll
        for (int d = 0; d < 2; ++d) {
            const float* sc = scal + d * 192;
#pragma unroll
            for (int ns = 0; ns < 4; ++ns) { f32x4 s = {0.f, 0.f, 0.f, 0.f};
#pragma unroll
                for (int kk = 0; kk < 2; ++kk) s = MFMA16(qa[kk], kf[ns][kk], s);
                const int sx = 16 * ns + fr; const float csx = sc[sx];
#pragma unroll
                for (int j = 0; j < 4; ++j) { const int t = 16 * mt + 4 * fq + j; const bool ok = d ? (sx >= t) : (sx <= t); const float val = ok ? s[j] * 0.125f * __expf(csx - sc[64 + t]) : 0.f; Sp[(4 * fq + j) * 72 + sx] = f2bf(val); } }
            LDSFENCE();
            f32x4 aS[5], aI[5];
#pragma unroll
            for (int et = 0; et < 5; ++et) { aS[et] = (f32x4){0.f, 0.f, 0.f, 0.f}; aI[et] = (f32x4){0.f, 0.f, 0.f, 0.f}; }
#pragma unroll
            for (int kk = 0; kk < 2; ++kk) { const bf16x8 sa = *(const bf16x8*)(Sp + fr * 72 + 32 * kk + 8 * fq);
#pragma unroll
                for (int et = 0; et < 5; ++et) { const bf16x8 vf = *(const bf16x8*)(Vt + (16 * et + fr) * 72 + 32 * kk + 8 * fq); aS[et] = MFMA16(sa, vf, aS[et]); }
#pragma unroll
                for (int et = 0; et < 4; ++et) { const bf16x8 cf = *(const bf16x8*)(C0d[d] + et * 1024 + 32 * kk); aI[et] = MFMA16(qa[kk], cf, aI[et]); }
                aI[4] = MFMA16(qa[kk], nf[d][kk], aI[4]); }
#pragma unroll
            for (int j = 0; j < 4; ++j) { const int t = 16 * mt + 4 * fq + j; const float mut = sc[64 + t]; const float fi = __expf(m0d[d] - mut); const float den = fi * aI[4][j] + aS[4][j];
                const float lim = __expf(-sc[128 + t] - mut); const float inv = frcp(fmaxf(fabsf(den), lim));
#pragma unroll
                for (int et = 0; et < 4; ++et) hacc[et][j] += (fi * aI[et][j] + aS[et][j]) * inv; }
            LDSFENCE();
        }
#pragma unroll
        for (int j = 0; j < 4; ++j) { const int tl = 4 * fq + j;
            float s1 = 0.f, s2 = 0.f;
#pragma unroll
            for (int et = 0; et < 4; ++et) { const float v = hacc[et][j]; s1 += v; s2 += v * v; }
#pragma unroll
            for (int o = 1; o < 16; o <<= 1) { s1 += __shfl_xor(s1, o); s2 += __shfl_xor(s2, o); }
            const float mean = s1 * (1.f / 64.f); const float var = fmaxf(s2 * (1.f / 64.f) - mean * mean, 0.f); const float rs = rsqrtf(var + EPS);
#pragma unroll
            for (int et = 0; et < 4; ++et) { const float y = (hacc[et][j] - mean) * rs * ng[et]; const float o = bf2f(Ot[tl * 72 + 16 * et + fr]); Ot[tl * 72 + 16 * et + fr] = f2bf(y * sigmoidf_(o)); } }
        LDSFENCE();
#pragma unroll
        for (int i = 0; i < 2; ++i) { const int idx = lane + 64 * i, tl = idx >> 3, cg = idx & 7; *(u32x4*)(MIX + (row0 + 16 * mt + tl) * DM + MIX_M + h * 64 + 8 * cg) = *(const u32x4*)(Ot + tl * 72 + 8 * cg); }
        LDSFENCE();
    }
}

template <bool FINAL> DI void lru_wave_unit(const Params& p, unsigned char* ldsw, int l, int b, int c, int blk, int lane, int dmask = 3) {
    asm volatile("" : "+v"(lane));
    const int fr = lane & 15, fq = lane >> 4;
    unsigned char* ws = p.ws; asm volatile("" : "+s"(ws));
    const bf16_t* P = (const bf16_t*)(ws + WS_P); bf16_t* MIX = (bf16_t*)(ws + WS_ACT); const bf16_t* LW = (const bf16_t*)(ws + WS_LW);
    float2* LAGG = (float2*)(ws + WS_LAGG); const float* CARRY = (const float*)(ws + WS_CARRY);
    bf16_t* seqb = (bf16_t*)ldsw;
    float2* priv = (float2*)(ldsw + 4608);
    const size_t rowb = (size_t)b * TT; const int t0 = c * 32; const int seg_lo = t0 < NC ? 0 : NC, seg_hi = t0 < NC ? NC : TT;
    const int chs = blk * 64 + lane;
#pragma unroll
    for (int it = 0; it < 4; ++it) { const int idx = lane + 64 * it, tl = idx >> 3, cg = idx & 7, t = t0 + tl, ch0 = blk * 64 + 8 * cg;
        float s[8]; { const float4 b0 = *(const float4*)(p.conv_b + l * 256 + ch0), b1 = *(const float4*)(p.conv_b + l * 256 + ch0 + 4); s[0] = b0.x; s[1] = b0.y; s[2] = b0.z; s[3] = b0.w; s[4] = b1.x; s[5] = b1.y; s[6] = b1.z; s[7] = b1.w; }
#pragma unroll
        for (int j = 0; j < 4; ++j) { const int tt = t + j - 2; if (tt >= seg_lo && tt < seg_hi) { const u32x4 xv = __builtin_nontemporal_load((const u32x4*)(P + (rowb + tt) * DINP + C_RX + ch0)); float f[8]; unpack8(xv, f);
                const float* cw = p.conv_w + (size_t)(l * 4 + j) * 256 + ch0; const float4 w0 = *(const float4*)cw, w1 = *(const float4*)(cw + 4);
                s[0] += w0.x * f[0]; s[1] += w0.y * f[1]; s[2] += w0.z * f[2]; s[3] += w0.w * f[3]; s[4] += w1.x * f[4]; s[5] += w1.y * f[5]; s[6] += w1.z * f[6]; s[7] += w1.w * f[7]; } }
        *(u32x4*)(seqb + tl * 72 + 8 * cg) = pack8(s); }
    LDSFENCE();
    float hreg[32];
#pragma unroll
    for (int d = 0; d < 2; ++d) {
        __builtin_amdgcn_sched_barrier(0);
        if (!FINAL && !((dmask >> d) & 1)) continue;
        const bf16_t* LWp = LW + ((size_t)((l * 2 + d) * 2) * 4 + blk) * 4096 + fr * 64 + 8 * fq;
        float gbr[4], gbi[4], sp8[4];
#pragma unroll
        for (int nt = 0; nt < 4; ++nt) { const int ch = blk * 64 + 16 * nt + fr; gbr[nt] = p.lru_b[(size_t)((l * 2 + d) * 2 + 0) * 256 + ch]; gbi[nt] = p.lru_b[(size_t)((l * 2 + d) * 2 + 1) * 256 + ch];
            sp8[nt] = 8.f * softplusf_(-p.lru_lam[(size_t)(l * 2 + d) * 256 + ch]); }
        const bool small_decay = __builtin_amdgcn_ballot_w64(fmaxf(fmaxf(sp8[0], sp8[1]), fmaxf(sp8[2], sp8[3])) >= 0.12f) == 0ull;
        const int nd = d ? (c < 8 ? 7 - c : 143 - c) : c;
        const size_t aidx = (((size_t)b * NCH32 + nd) * 2 + d) * 256 + chs;
        float hst = FINAL ? CARRY[aidx] : 0.f, ap = 1.f;
#pragma unroll
        for (int mi = 0; mi < 2; ++mi) { const int mt = d ? 1 - mi : mi;
            f32x4 ar[4], ai[4];
#pragma unroll
            for (int nt = 0; nt < 4; ++nt) { ar[nt] = (f32x4){0.f, 0.f, 0.f, 0.f}; ai[nt] = (f32x4){0.f, 0.f, 0.f, 0.f}; }
            { const bf16_t* LWq = LWp; asm volatile("" : "+v"(LWq));
#pragma unroll
            for (int kk = 0; kk < 2; ++kk) { const bf16x8 a = *(const bf16x8*)(seqb + (16 * mt + fr) * 72 + 32 * kk + 8 * fq);
#pragma unroll
                for (int nt = 0; nt < 4; ++nt) { const bf16x8 w0 = *(const bf16x8*)(LWq + nt * 1024 + 32 * kk), w1 = *(const bf16x8*)(LWq + 16384 + nt * 1024 + 32 * kk); ar[nt] = MFMA16(a, w0, ar[nt]); ai[nt] = MFMA16(a, w1, ai[nt]); } } }
#pragma unroll
            for (int nt = 0; nt < 4; ++nt)
#pragma unroll
                for (int jp = 0; jp < 2; ++jp) { const int tl = 4 * fq + 2 * jp;
                    const f32x2_hw xr = (f32x2_hw){ar[nt][2 * jp], ar[nt][2 * jp + 1]} + gbr[nt], xi = (f32x2_hw){ai[nt][2 * jp], ai[nt][2 * jp + 1]} + gbi[nt];
                    const f32x2_hw xr2 = xr * -1.4426950408889634f, xi2 = xi * -1.4426950408889634f;
                    f32x2_hw ex, ey; ex.x = __builtin_amdgcn_exp2f(xr2.x); ex.y = __builtin_amdgcn_exp2f(xr2.y); ey.x = __builtin_amdgcn_exp2f(xi2.x); ey.y = __builtin_amdgcn_exp2f(xi2.y);
                    ex = ex + 1.f; ey = ey + 1.f;
                    const f32x2_hw den = ex * ey; f32x2_hw R; R.x = frcp(den.x); R.y = frcp(den.y);
                    const f32x2_hw r = ey * R, ig = ex * R;
                    const f32x2_hw la = r * -sp8[nt];
                    f32x2_hw a, nem;
                    if (small_decay) { a = la * (la * (la * (la * (la * 0.008333334f + 0.041666668f) + 0.16666667f) + 0.5f) + 1.f) + 1.f; const f32x2_hw x2 = la * 2.f; nem = (x2 * (x2 * (x2 * (x2 * (x2 * 0.008333334f + 0.041666668f) + 0.16666667f) + 0.5f) + 1.f)) * -1.f; }
                    else { a.x = __expf(la.x); a.y = __expf(la.y); nem.x = neg_expm1(2.f * la.x); nem.y = neg_expm1(2.f * la.y); }
                    f32x2_hw sq; sq.x = __builtin_amdgcn_sqrtf(nem.x); sq.y = __builtin_amdgcn_sqrtf(nem.y);
                    const f32x2_hw sv = {bf2f(seqb[(16 * mt + tl) * 72 + 16 * nt + fr]), bf2f(seqb[(16 * mt + tl + 1) * 72 + 16 * nt + fr])};
                    const f32x2_hw u = sq * ig * sv;
                    priv[tl * 64 + 16 * nt + fr] = make_float2(a.x, u.x); priv[(tl + 1) * 64 + 16 * nt + fr] = make_float2(a.y, u.y); }
            LDSFENCE();
#pragma unroll
            for (int ti = 0; ti < 16; ++ti) { const int tl = d ? 15 - ti : ti; const float2 au = priv[tl * 64 + lane]; hst = au.x * hst + au.y; ap *= au.x;
                if (FINAL) { if (d == 0) hreg[16 * mt + tl] = hst; else hreg[16 * mt + tl] += hst; } }
            LDSFENCE();
        }
        if (!FINAL) LAGG[aidx] = make_float2(ap, hst);
    }
    if (FINAL) {
#pragma unroll
        for (int t8 = 0; t8 < 32; t8 += 8) { float yv[8];
#pragma unroll
            for (int t = 0; t < 8; ++t) yv[t] = bf2f(__builtin_nontemporal_load(&P[(rowb + t0 + t8 + t) * DINP + C_RY + chs]));
#pragma unroll
            for (int t = 0; t < 8; ++t) MIX[(rowb + t0 + t8 + t) * DM + MIX_R + chs] = f2bf(hreg[t8 + t] * gelu_tanh(yv[t])); }
    }
}

DI void lru_scan_unit(const Params& p, int b) {
    int tid_l = threadIdx.x; asm volatile("" : "+v"(tid_l)); const int tid = tid_l, d = tid >> 8, ch = tid & 255;
    unsigned char* ws = p.ws; asm volatile("" : "+s"(ws));
    const float2* LAGG = (const float2*)(ws + WS_LAGG); float* CARRY = (float*)(ws + WS_CARRY);
    float carry = 0.f;
#pragma unroll 1
    for (int n0 = 0; n0 < NCH32; n0 += 17) { float2 v[17];
#pragma unroll
        for (int k = 0; k < 17; ++k) v[k] = LAGG[(((size_t)b * NCH32 + n0 + k) * 2 + d) * 256 + ch];
#pragma unroll
        for (int k = 0; k < 17; ++k) { CARRY[(((size_t)b * NCH32 + n0 + k) * 2 + d) * 256 + ch] = carry; carry = v[k].x * carry + v[k].y; } }
}

#define LAS __attribute__((address_space(3)))
#define XB_TMO      128
#define XB_XCNT(j)  (256  + 64 * (j))
#define XB_XSUB(j)  (1280 + 64 * (j))
#define XB_XGEN(j)  (2304 + 64 * (j))
#define XB_TOP      3328
#define XB_TOPGEN   3392
#define XCD_BAR_WORDS 3456
#define XB_SPIN_CAP (1u << 18)

__device__ __forceinline__ unsigned xb_ld(unsigned* p)              { return __hip_atomic_load(p, __ATOMIC_RELAXED, __HIP_MEMORY_SCOPE_AGENT); }
__device__ __forceinline__ unsigned xb_add(unsigned* p, unsigned v) { return __hip_atomic_fetch_add(p, v, __ATOMIC_RELAXED, __HIP_MEMORY_SCOPE_AGENT); }
__device__ __forceinline__ unsigned xb_xcc_id() { return (unsigned)__builtin_amdgcn_s_getreg((3 << 11) | 20) & 0xFu; }
#define XB_SPIN(cond, bar) do { unsigned _sp = 0; while (cond) { __builtin_amdgcn_s_sleep(1); \
    if ((++_sp & 255u) == 0u) { if (xb_ld(&(bar)[XB_TMO])) break; if (_sp > XB_SPIN_CAP) { atomicAdd(&(bar)[XB_TMO], 1u); break; } } } } while (0)

struct XcdBarrier {
    unsigned* bar; unsigned x;
    volatile LAS unsigned* st;
};

__device__ __forceinline__ XcdBarrier xcd_barrier_post(unsigned* bar, volatile LAS unsigned* st) {
    XcdBarrier b; b.bar = bar; b.x = xb_xcc_id(); b.st = st;
    if (threadIdx.x == 0) (void)xb_add(&bar[XB_XCNT(b.x)], 1u);
    return b;
}
__device__ __forceinline__ void xcd_barrier_complete(unsigned* bar, unsigned x, unsigned& nloc, unsigned& nx) {
    const unsigned G = gridDim.x * gridDim.y * gridDim.z;
    unsigned sum, cnt, mine, sp = 0u;
    for (;;) {
        sum = 0u; cnt = 0u; mine = 0u;
#pragma unroll
        for (unsigned j = 0; j < 16; ++j) { const unsigned c = xb_ld(&bar[XB_XCNT(j)]); sum += c; cnt += (c > 0u) ? 1u : 0u; mine = (j == x) ? c : mine; }
        if (sum == G) break;
        __builtin_amdgcn_s_sleep(1);
        if ((++sp & 255u) == 0u) { if (xb_ld(&bar[XB_TMO])) break; if (sp > XB_SPIN_CAP) { atomicAdd(&bar[XB_TMO], 1u); break; } }
    }
    nloc = mine > 0u ? mine : 1u; nx = cnt > 0u ? cnt : 1u;
}

__device__ __forceinline__ void xcd_barrier(const XcdBarrier& b) {
    asm volatile("s_waitcnt vmcnt(0)" ::: "memory");
    __syncthreads();
    if (threadIdx.x == 0) {
        unsigned* bar = b.bar;
        __builtin_amdgcn_s_waitcnt(0);
        unsigned nloc = b.st[0], nx = b.st[1];
        if (nloc == 0u) { xcd_barrier_complete(bar, b.x, nloc, nx); b.st[0] = nloc; b.st[1] = nx; }
        const unsigned old = xb_add(&bar[XB_XSUB(b.x)], 1u);
        const unsigned gen = old / nloc;
        if (old + 1u == (gen + 1u) * nloc) {
            __builtin_amdgcn_fence(__ATOMIC_RELEASE, "agent");
            asm volatile("s_waitcnt vmcnt(0)" ::: "memory");
            const unsigned og = xb_add(&bar[XB_TOP], 1u);
            const unsigned tg = og / nx;
            if (og + 1u == (tg + 1u) * nx) xb_add(&bar[XB_TOPGEN], 1u);
            else XB_SPIN(xb_ld(&bar[XB_TOPGEN]) == tg, bar);
            __builtin_amdgcn_fence(__ATOMIC_ACQUIRE, "agent");
            xb_add(&bar[XB_XGEN(b.x)], 1u);
            asm volatile("s_waitcnt vmcnt(0)" ::: "memory");
        } else {
            XB_SPIN(xb_ld(&bar[XB_XGEN(b.x)]) == gen, bar);
            __builtin_amdgcn_fence(__ATOMIC_ACQUIRE, "agent");
            asm volatile("s_waitcnt vmcnt(0)" ::: "memory");
        }
    }
    __syncthreads();
}

typedef const volatile __attribute__((address_space(4))) Params* KParamsPtr;
DI Params kload() { KParamsPtr kp = (KParamsPtr)__builtin_amdgcn_kernarg_segment_ptr(); Params q;
    q.x = (const float*)kp->x;
    q.c = (const float*)kp->c;
    q.ctx = (const float*)kp->ctx;
    q.c_ctx = (const float*)kp->c_ctx;
    q.w_ada = (const float*)kp->w_ada;
    q.b_ada = (const float*)kp->b_ada;
    q.norm_gain = (const float*)kp->norm_gain;
    q.w_in = (const float*)kp->w_in;
    q.w_out = (const float*)kp->w_out;
    q.attn_sink = (const float*)kp->attn_sink;
    q.mgate_b = (const float*)kp->mgate_b;
    q.mnorm = (const float*)kp->mnorm;
    q.conv_w = (const float*)kp->conv_w;
    q.conv_b = (const float*)kp->conv_b;
    q.lru_w = (const float*)kp->lru_w;
    q.lru_b = (const float*)kp->lru_b;
    q.lru_lam = (const float*)kp->lru_lam;
    q.w_f1 = (const float*)kp->w_f1;
    q.w_f2 = (const float*)kp->w_f2;
    q.out = (float*)kp->out; q.ws = (unsigned char*)kp->ws; q.ph_lo = 0; q.ph_hi = 0; return q; }

__global__ void __launch_bounds__(NTHR, 2) fwd_kernel(Params p) {
    extern __shared__ __attribute__((aligned(16))) unsigned char lds[];
    cg::grid_group grid = cg::this_grid();
    const int lo = p.ph_lo, hi = p.ph_hi;
    volatile LAS unsigned* bst = (volatile LAS unsigned*)((LAS unsigned char*)lds + (LDS_BYTES - 64));
    if (threadIdx.x < 16) bst[threadIdx.x] = 0u;
    __syncthreads();
    (void)xcd_barrier_post((unsigned*)(p.ws + WS_BAR), bst);
    if (lo > 1000) grid.sync();
#ifndef ENMASK
#define ENMASK 0xffff
#endif
#define EN(b) ((ENMASK >> (b)) & 1)
#ifndef DUPMASK
#define DUPMASK 0
#endif
#define REP(b) for (int rep_ = 0; rep_ < 1 + ((DUPMASK >> (b)) & 1); ++rep_)
#define IN(k) (lo <= (k) && (k) < hi)
#ifndef DUPMASK
#define DUPMASK 0
#endif
#define SEAM(k) do { if (IN(k) && IN((k) + 1)) { XcdBarrier xb_; xb_.bar = (unsigned*)(((KParamsPtr)__builtin_amdgcn_kernarg_segment_ptr())->ws + WS_BAR); xb_.x = xb_xcc_id(); xb_.st = (volatile LAS unsigned*)((LAS unsigned char*)lds + (LDS_BYTES - 64)); xcd_barrier(xb_); if ((DUPMASK >> 15) & 1) xcd_barrier(xb_); } } while (0)
#define LAUNDER() const Params q = kload(); int l = l0; unsigned char* ws = q.ws; int G = gridDim.x, bid = blockIdx.x; asm volatile("" : "+s"(l), "+s"(ws), "+s"(G), "+s"(bid))
    if (EN(0) && IN(0)) REP(0) { const Params q = kload(); phase_setup(q, lds); }
    SEAM(0);
#pragma unroll 1
    for (int l0 = 0; l0 < DEPTH; ++l0) {
        const int pb = 1 + 9 * l0;
        if (EN(1) && IN(pb + 0)) REP(1) { LAUNDER(); phase_rows(q, lds, l, 0, rep_ ? 0.f : 1.f); }
        SEAM(pb + 0);
        if (EN(2) && IN(pb + 1)) REP(2) { LAUNDER(); pg8::Gemm g{(bf16_t*)(ws + WS_ACT), (const bf16_t*)(ws + WS_WIN) + (size_t)l * DINP * 1024, MR, DINP, 1024}; pg8::StaticOrder S; S.init(MR, DINP, G, bid); pg8::EpiStore E{(bf16_t*)(ws + WS_P), DINP};
            pg8::gemm_phase<pg8::EpiStore, pg8::StaticOrder, true, true>((PG8_LAS unsigned char*)lds, g, S, E); }
        SEAM(pb + 1);
        if (IN(pb + 2)) REP(3) { LAUNDER();
            const bool need_ctx = l < DEPTH - 1;
            const int nA = 1024 + (need_ctx ? 64 : 0), nM = NB * NCH;
#pragma unroll 1
            for (int u = bid; u < nA + nM; u += G) {
                if (u < 1024) { if (EN(3)) REP(16) attn_unit(q, lds, l, u >> 7, (u >> 1) & 63, u & 1, false); }
                else if (u < nA) { const int v = u - 1024; if (EN(12)) attn_unit(q, lds, l, v >> 3, (v >> 1) & 3, v & 1, true); }
                else { const int v = u - nA; if (EN(10)) REP(10) mlstm_local_unit(q, lds, l, v / NCH, v % NCH); }
            }
            __syncthreads();
            { int tidw = threadIdx.x; asm volatile("" : "+v"(tidw)); const int wave = __builtin_amdgcn_readfirstlane(tidw >> 6), lane = tidw & 63;
              { const int W = G * 8, wr = ((bid + 96) % G) * 8 + wave, nU = NB * NCH32 * 4, nFull = (nU / W) * W;
#pragma unroll 1
                for (int wu = wr; wu < nFull; wu += W) { const int v = wu >> 2; if (EN(9)) REP(9) lru_wave_unit<false>(q, lds + wave * 12800, l, v / NCH32, v % NCH32, wu & 3, lane); }
                if (wr < 2 * (nU - nFull)) { const int wu = nFull + (wr >> 1), v = wu >> 2; if (EN(9)) REP(9) lru_wave_unit<false>(q, lds + wave * 12800, l, v / NCH32, v % NCH32, wu & 3, lane, 1 << (wr & 1)); } } }
        }
        SEAM(pb + 2);
        if (EN(4) && IN(pb + 3)) REP(4) { LAUNDER();
#pragma unroll 1
            for (int u = bid; u < 512 + NB; u += G) { if (u >= NB) mlstm_scan_unit(q, lds, u - NB); else lru_scan_unit(q, u); } }
        SEAM(pb + 3);
        if (IN(pb + 4)) REP(5) { LAUNDER();
            { int tidw = threadIdx.x; asm volatile("" : "+v"(tidw)); const int wave = __builtin_amdgcn_readfirstlane(tidw >> 6), lane = tidw & 63;
              const int nMW = NB * NCH * 4, nLW = NB * NCH32 * 4;
              const int W = G * 8, w = bid * 8 + wave;
              if (W == 2048) {
                  int m0 = -1, m1 = -1, l0 = 0, nl = 0;
                  if (w < 1152) { m0 = w; l0 = 2 * w; nl = 2; }
                  else if (w < 1664) { const int i = w - 1152; m0 = 1152 + 2 * i; m1 = m0 + 1; l0 = 2304 + i; nl = 1; }
                  else { const int i = w - 1664; l0 = 2816 + 4 * i; nl = 4; }
                  if (m0 >= 0) { const int v = m0 >> 2; if (EN(5)) REP(13) mlstm_out_wave_unit(q, lds + wave * 17920, l, v / NCH, v % NCH, m0 & 3, lane); }
                  if (m1 >= 0) { const int v = m1 >> 2; if (EN(5)) mlstm_out_wave_unit(q, lds + wave * 17920, l, v / NCH, v % NCH, m1 & 3, lane); }
#pragma unroll 1
                  for (int k = 0; k < nl; ++k) { const int u = l0 + k, v = u >> 2; if (EN(11)) REP(14) lru_wave_unit<true>(q, lds + wave * 17920, l, v / NCH32, v % NCH32, u & 3, lane); }
              } else {
#pragma unroll 1
              for (int wu = w; wu < nMW + nLW; wu += W) {
                  if (wu < nMW) { const int v = wu >> 2; if (EN(5)) REP(13) mlstm_out_wave_unit(q, lds + wave * 17920, l, v / NCH, v % NCH, wu & 3, lane); }
                  else { const int w2 = wu - nMW, v = w2 >> 2; if (EN(11)) REP(14) lru_wave_unit<true>(q, lds + wave * 17920, l, v / NCH32, v % NCH32, w2 & 3, lane); } } } }
        }
        SEAM(pb + 4);
        if (EN(6) && IN(pb + 5)) REP(6) { LAUNDER(); __syncthreads(); pg8::Gemm g{(bf16_t*)(ws + WS_ACT), (const bf16_t*)(ws + WS_WOUT) + (size_t)l * 1024 * 1024, MR, 1024, 1024}; pg8::StaticOrder S; S.init(MR, 1024, G, bid, l == DEPTH - 1); pg8::EpiStore E{(bf16_t*)(ws + WS_Y), 1024};
            pg8::gemm_phase<pg8::EpiStore, pg8::StaticOrder, true, true>((PG8_LAS unsigned char*)lds, g, S, E); }
        SEAM(pb + 5);
        if (EN(1) && IN(pb + 6)) for (int rep_ = 0; rep_ < 1 + (((DUPMASK >> 1) & 1) && l0 > 0); ++rep_) { LAUNDER(); phase_rows(q, lds, l, 1, rep_ ? 0.f : 1.f); }
        SEAM(pb + 6);
        if (EN(7) && IN(pb + 7)) REP(7) { LAUNDER(); pg8::Gemm g{(bf16_t*)(ws + WS_ACT), (const bf16_t*)(ws + WS_WF1) + (size_t)l * 2 * DFF * 1024, MR, 2 * DFF, 1024}; pg8::StaticOrder S; S.init(MR, 2 * DFF, G, bid, l == DEPTH - 1); pg8::EpiSwiglu E{(bf16_t*)(ws + WS_P), DFF};
            pg8::gemm_phase<pg8::EpiSwiglu, pg8::StaticOrder, true, true>((PG8_LAS unsigned char*)lds, g, S, E); }
        SEAM(pb + 7);
        if (EN(8) && IN(pb + 8)) REP(8) { LAUNDER(); pg8::Gemm g{(bf16_t*)(ws + WS_P), (const bf16_t*)(ws + WS_WF2) + (size_t)l * 1024 * DFF, MR, 1024, DFF}; pg8::StaticOrder S; S.init(MR, 1024, G, bid, l == DEPTH - 1); pg8::EpiStore E{(bf16_t*)(ws + WS_Y), 1024};
            pg8::gemm_phase<pg8::EpiStore, pg8::StaticOrder, true, true>((PG8_LAS unsigned char*)lds, g, S, E);
            if (rep_ == 0 && l < DEPTH - 1) { __syncthreads(); convert_layer(q, lds, l + 1, 32, G - 32); } }
        SEAM(pb + 8);
    }
    if (EN(1) && IN(37)) { const Params q = kload(); int l = 3; asm volatile("" : "+s"(l)); phase_rows(q, lds, l, 2); }
#undef IN
#undef SEAM
}

#ifndef MK_PER_PHASE
#define MK_PER_PHASE 0
#endif
constexpr int N_PHASES = 38;

extern "C" void kernel_launch(void* const* d_in, const int* in_sizes, int n_in, void* d_out, int out_size, void* d_ws, size_t ws_size, hipStream_t stream) {
    static int grid = 0;
    if (grid == 0) {
        if (n_in != 19 || ws_size < WS_END) { fprintf(stderr, "kernel_launch: unexpected n_in %d or ws_size %zu (need %zu)\n", n_in, ws_size, (size_t)WS_END); grid = -1; return; }
        if (hipFuncSetAttribute((const void*)fwd_kernel, hipFuncAttributeMaxDynamicSharedMemorySize, LDS_BYTES) != hipSuccess) { fprintf(stderr, "kernel_launch: hipFuncSetAttribute failed\n"); grid = -1; return; }
        int dev = 0, cus = 0, per_cu = 0;
        hipGetDevice(&dev); hipDeviceGetAttribute(&cus, hipDeviceAttributeMultiprocessorCount, dev);
        hipOccupancyMaxActiveBlocksPerMultiprocessor(&per_cu, (const void*)fwd_kernel, NTHR, LDS_BYTES);
        if (per_cu < 1) { fprintf(stderr, "kernel_launch: occupancy query says %d blocks per CU\n", per_cu); per_cu = 1; }
        (void)hipGetLastError();
        grid = cus;
    }
    if (grid < 0) return;
    Params p{};
    const float** pp = (const float**)&p;
    for (int i = 0; i < 19; ++i) pp[i] = (const float*)d_in[i];
    p.out = (float*)d_out; p.ws = (unsigned char*)d_ws;
#if MK_PER_PHASE
    for (int k = 0; k < N_PHASES; ++k) { p.ph_lo = k; p.ph_hi = k + 1; hipLaunchKernelGGL(fwd_kernel, dim3(grid), dim3(NTHR), LDS_BYTES, stream, p); }
#else
    p.ph_lo = 0; p.ph_hi = N_PHASES;
    if (hipMemsetAsync((char*)d_ws + WS_BAR, 0, 16384, stream) != hipSuccess) { fprintf(stderr, "kernel_launch: memset failed\n"); return; }
    void* args[] = {&p};
    hipError_t e = hipLaunchCooperativeKernel((const void*)fwd_kernel, dim3(grid), dim3(NTHR), args, LDS_BYTES, stream);
    if (e != hipSuccess) fprintf(stderr, "cooperative launch failed: %s (grid %d)\n", hipGetErrorString(e), grid);
#endif
}
```

```cpp
#include <hip/hip_runtime.h>
#include <hip/hip_cooperative_groups.h>
#include <cstdio>
#include <cstdint>
namespace cg = cooperative_groups;
namespace pg8 {
#define PG8_LAS __attribute__((address_space(3)))
typedef unsigned short bf16_t;
typedef short bf16x8 __attribute__((ext_vector_type(8)));
typedef float f32x4 __attribute__((ext_vector_type(4)));
typedef unsigned u32x4 __attribute__((ext_vector_type(4)));
constexpr int BM = 256, BK = 64, HALF = 128, HTB = HALF * BK * 2  , STAGE_BYTES = 8 * HTB, NXCD = 8, WGM = 8;

__host__ __device__ __forceinline__ int lds_byte(int r, int c) { const int st = (r >> 4) * 2 + (c >> 5), rr = r & 15, cc = c & 31, ob = rr * 64 + cc * 2; return st * 1024 + (ob ^ (((ob >> 9) & 1) << 5)); }
__host__ __device__ __forceinline__ void stage_rc(int b, int& R, int& C) { const int st = b / 1024, sb = b % 1024, swz = sb ^ (((sb >> 9) & 1) << 5); R = (st >> 1) * 16 + swz / 64; C = (st & 1) * 32 + (swz % 64) / 2; }
__host__ __device__ __forceinline__ int perm32(int rho) { const int n = rho >> 4, i = rho & 15; return 8 * (i >> 2) + 4 * n + (i & 3); }

struct Unit { int pm, pn; };
struct Gemm { const bf16_t* A; const bf16_t* Bt; int M, N, K; };

struct StaticOrder {
    int nM, nN, nwg, G, c, skipc;
    __host__ __device__ void init(int M, int N, int G_, int c_, int skipc_ = 0) { nM = skipc_ ? (M / BM) / 17 * 16 : M / BM; nN = N / BM; nwg = nM * nN; G = G_; c = c_; skipc = skipc_; }
    __host__ __device__ bool next(int i, Unit& u) const {
        const long L = (long)i * G + c; if (L >= nwg) return false;
        int wgid = (int)L; { const int q = nwg / NXCD, r = nwg % NXCD, xcd = wgid % NXCD, off = wgid / NXCD; wgid = (xcd < r ? xcd * (q + 1) : r * (q + 1) + (xcd - r) * q) + off; }
        const int nig = WGM * nN, gid = wgid / nig, fm = gid * WGM, gsz = (nM - fm) < WGM ? (nM - fm) : WGM;
        u.pm = fm + ((wgid % nig) % gsz); u.pn = (wgid % nig) / gsz; if (skipc) u.pm = (u.pm >> 4) * 17 + 1 + (u.pm & 15); return true;
    }
    __device__ __forceinline__ void a_ready(const Unit&) const {}
    __device__ __forceinline__ void done(const Unit&) const {}
};

typedef __bf16 bf16x2_cv __attribute__((ext_vector_type(2)));
typedef float f32x2_cv __attribute__((ext_vector_type(2)));
__device__ __forceinline__ unsigned cvt_pk_bf16(float lo, float hi) { const f32x2_cv v = {lo, hi}; const bf16x2_cv b = __builtin_convertvector(v, bf16x2_cv); return __builtin_bit_cast(unsigned, b); }
typedef float f32x2 __attribute__((ext_vector_type(2)));
template <class Epi, class Sched, bool ALIGN_EPI = false, bool SP2 = false>
__device__ __forceinline__ void gemm_phase(PG8_LAS unsigned char* lds, const Gemm g, const Sched& S, const Epi& E) {
    int tid_l = threadIdx.x; asm volatile("" : "+v"(tid_l)); const int tid = tid_l, wid = __builtin_amdgcn_readfirstlane(tid >> 6), lane = tid & 63, wr = wid >> 2, wc = wid & 3, fr = lane & 15, fq = lane >> 4;
    const int K = g.K, nt = K / BK;
    unsigned voffA[2], voffB[2];
#pragma unroll
    for (int i = 0; i < 2; ++i) { int R, C; stage_rc(tid * 16 + i * 8192, R, C); const int Rb = Epi::PERM ? ((R & ~31) + perm32(R & 31)) : R;
        voffA[i] = (unsigned)(R * K + C) * 2u; voffB[i] = (unsigned)(Rb * K + C) * 2u; }
    const size_t kstep = (size_t)(BK * 2);
    const size_t hstep = (size_t)HALF * K * 2;
    const size_t tstep = 2 * hstep;
    const unsigned ldsw = (unsigned)wid * 1024u;
    const int aoff = lds_byte(wr * 64 + fr, fq * 8), boff = lds_byte(wc * 32 + fr, fq * 8);
#define PG8_SA(b, h) (((b) * 2 + (h)) * HTB)
#define PG8_SB(b, h) ((4 + (b) * 2 + (h)) * HTB)
#define PG8_STAGE(bufoff, gbase, voff) do { _Pragma("unroll") for (int _i = 0; _i < 2; ++_i) \
        __builtin_amdgcn_global_load_lds((const unsigned*)((const char*)(gbase) + (voff)[_i]), (PG8_LAS unsigned*)(lds + (bufoff) + ldsw + _i * 8192), 16, 0, 0); } while (0)
#define PG8_LDA(dst, b, h) do { _Pragma("unroll") for (int m = 0; m < 4; ++m) _Pragma("unroll") for (int k = 0; k < 2; ++k) dst[m][k] = *(const PG8_LAS bf16x8*)(lds + PG8_SA(b, h) + aoff + m * 2048 + k * 1024); } while (0)
#define PG8_LDB(dst, b, h) do { _Pragma("unroll") for (int n = 0; n < 2; ++n) _Pragma("unroll") for (int k = 0; k < 2; ++k) dst[n][k] = *(const PG8_LAS bf16x8*)(lds + PG8_SB(b, h) + boff + n * 2048 + k * 1024); } while (0)
#define PG8_MMA(ai, bj, At, Bt) do { __builtin_amdgcn_s_setprio(1); _Pragma("unroll") for (int m = 0; m < 4; ++m) _Pragma("unroll") for (int n = 0; n < 2; ++n) _Pragma("unroll") for (int k = 0; k < 2; ++k) \
        acc[ai][bj][m][n] = __builtin_amdgcn_mfma_f32_16x16x32_bf16(Bt[n][k], At[m][k], acc[ai][bj][m][n], 0, 0, 0); __builtin_amdgcn_s_setprio(0); } while (0)
#define PG8_WAIT_V(n) asm volatile("s_waitcnt vmcnt(" #n ")" ::: "memory")
#define PG8_WAIT_L(n) asm volatile("s_waitcnt lgkmcnt(" #n ")" ::: "memory")
#define PG8_BAR __builtin_amdgcn_s_barrier()
#define PG8_SCHED __builtin_amdgcn_sched_barrier(0)
    Unit cur, nxt; int ui = 0;
    if (!S.next(0, cur)) return;
    f32x4 acc[2][2][4][2];
#pragma unroll
    for (int a = 0; a < 2; ++a)
#pragma unroll
        for (int b = 0; b < 2; ++b)
#pragma unroll
            for (int m = 0; m < 4; ++m)
#pragma unroll
                for (int n = 0; n < 2; ++n) acc[a][b][m][n] = (f32x4){0.f, 0.f, 0.f, 0.f};
    bf16x8 At[4][2], B0[2][2], B1[2][2];
    const char* cA = (const char*)g.A + (size_t)cur.pm * tstep; const char* cB = (const char*)g.Bt + (size_t)cur.pn * tstep;
    S.a_ready(cur);
    if constexpr (SP2) {
        PG8_STAGE(PG8_SB(0, 0), cB, voffB); PG8_STAGE(PG8_SB(0, 1), cB + hstep, voffB); PG8_STAGE(PG8_SA(0, 0), cA, voffA); PG8_STAGE(PG8_SA(0, 1), cA + hstep, voffA);
        if (wr == 1) PG8_BAR;
        PG8_WAIT_V(2); PG8_BAR;
        PG8_STAGE(PG8_SB(1, 0), cB + kstep, voffB); PG8_STAGE(PG8_SA(1, 0), cA + kstep, voffA); PG8_STAGE(PG8_SB(1, 1), cB + hstep + kstep, voffB);
        PG8_WAIT_V(6); PG8_BAR;
    } else {
        PG8_STAGE(PG8_SB(0, 0), cB, voffB); PG8_STAGE(PG8_SA(0, 0), cA, voffA); PG8_STAGE(PG8_SB(0, 1), cB + hstep, voffB); PG8_STAGE(PG8_SA(0, 1), cA + hstep, voffA);
        if (wr == 1) PG8_BAR;
        PG8_WAIT_V(4); PG8_BAR;
        PG8_STAGE(PG8_SB(1, 0), cB + kstep, voffB); PG8_STAGE(PG8_SA(1, 0), cA + kstep, voffA); PG8_STAGE(PG8_SB(1, 1), cB + hstep + kstep, voffB);
        PG8_WAIT_V(6); PG8_BAR;
    }
    for (;;) {
        const bool has_next = S.next(ui + 1, nxt);
        const char* nA = has_next ? (const char*)g.A + (size_t)nxt.pm * tstep : cA; const char* nB = has_next ? (const char*)g.Bt + (size_t)nxt.pn * tstep : cB;
        for (int t = 0; t < nt; t += 2) {
            const bool last = (t == nt - 2);
            const char* a1 = cA + (size_t)(t + 1) * kstep;
            const char* a2 = last ? nA : cA + (size_t)(t + 2) * kstep; const char* b2 = last ? nB : cB + (size_t)(t + 2) * kstep;
            const char* a3 = a2 + kstep; const char* b3 = b2 + kstep;
            if (last && has_next) S.a_ready(nxt);
            if constexpr (SP2) {
            PG8_LDB(B0, 0, 0); PG8_LDB(B1, 0, 1); PG8_SCHED; PG8_LDA(At, 0, 0); PG8_STAGE(PG8_SA(1, 1), a1 + hstep, voffA);
            PG8_WAIT_V(8); PG8_WAIT_L(0); PG8_BAR; PG8_MMA(0, 0, At, B0); PG8_MMA(0, 1, At, B1); PG8_BAR; PG8_SCHED;
            PG8_LDA(At, 0, 1); PG8_STAGE(PG8_SB(0, 0), b2, voffB); PG8_STAGE(PG8_SB(0, 1), b2 + hstep, voffB); PG8_STAGE(PG8_SA(0, 0), a2, voffA);
            PG8_WAIT_V(8); PG8_WAIT_L(0); PG8_BAR; PG8_MMA(1, 0, At, B0); PG8_MMA(1, 1, At, B1); PG8_BAR; PG8_SCHED;
            PG8_LDB(B0, 1, 0); PG8_LDB(B1, 1, 1); PG8_SCHED; PG8_LDA(At, 1, 0); PG8_STAGE(PG8_SA(0, 1), a2 + hstep, voffA);
            PG8_WAIT_V(8); PG8_WAIT_L(0); PG8_BAR; PG8_MMA(0, 0, At, B0); PG8_MMA(0, 1, At, B1); PG8_BAR; PG8_SCHED;
            PG8_LDA(At, 1, 1); PG8_STAGE(PG8_SB(1, 0), b3, voffB); PG8_STAGE(PG8_SB(1, 1), b3 + hstep, voffB); PG8_STAGE(PG8_SA(1, 0), a3, voffA);
            PG8_WAIT_V(8); PG8_WAIT_L(0); PG8_BAR; PG8_MMA(1, 0, At, B0); PG8_MMA(1, 1, At, B1); PG8_BAR; PG8_SCHED;
            } else {
            PG8_LDB(B0, 0, 0); PG8_SCHED; PG8_LDA(At, 0, 0); PG8_STAGE(PG8_SA(1, 1), a1 + hstep, voffA);
            PG8_WAIT_L(8); PG8_BAR; PG8_WAIT_L(0); PG8_MMA(0, 0, At, B0); PG8_BAR; PG8_SCHED;
            PG8_LDB(B1, 0, 1); PG8_STAGE(PG8_SB(0, 0), b2, voffB);
            PG8_BAR; PG8_WAIT_L(0); PG8_MMA(0, 1, At, B1); PG8_BAR;
            PG8_LDA(At, 0, 1); PG8_STAGE(PG8_SA(0, 0), a2, voffA);
            PG8_BAR; PG8_WAIT_L(0); PG8_MMA(1, 0, At, B0); PG8_BAR; PG8_SCHED;
            PG8_STAGE(PG8_SB(0, 1), b2 + hstep, voffB);
            PG8_WAIT_V(6); PG8_BAR; PG8_MMA(1, 1, At, B1); PG8_BAR;
            PG8_LDB(B0, 1, 0); PG8_SCHED; PG8_LDA(At, 1, 0); PG8_STAGE(PG8_SA(0, 1), a2 + hstep, voffA);
            PG8_WAIT_L(8); PG8_BAR; PG8_WAIT_L(0); PG8_MMA(0, 0, At, B0); PG8_BAR; PG8_SCHED;
            PG8_LDB(B1, 1, 1); PG8_STAGE(PG8_SB(1, 0), b3, voffB);
            PG8_BAR; PG8_WAIT_L(0); PG8_MMA(0, 1, At, B1); PG8_BAR;
            PG8_LDA(At, 1, 1); PG8_STAGE(PG8_SA(1, 0), a3, voffA);
            PG8_BAR; PG8_WAIT_L(0); PG8_MMA(1, 0, At, B0); PG8_BAR; PG8_SCHED;
            PG8_STAGE(PG8_SB(1, 1), b3 + hstep, voffB);
            PG8_WAIT_V(6); PG8_BAR; PG8_MMA(1, 1, At, B1); PG8_BAR;
            }
        }
        if constexpr (ALIGN_EPI) { if (wr == 0) PG8_BAR; }
        if constexpr (!Epi::AFTER_DRAIN) { E(acc, cur, wr, wc, fr, fq); S.done(cur); }
        if (!has_next) break;
#pragma unroll
        for (int a = 0; a < 2; ++a)
#pragma unroll
            for (int b = 0; b < 2; ++b)
#pragma unroll
                for (int m = 0; m < 4; ++m)
#pragma unroll
                    for (int n = 0; n < 2; ++n) acc[a][b][m][n] = (f32x4){0.f, 0.f, 0.f, 0.f};
        cur = nxt; cA = nA; cB = nB; ++ui;
        if constexpr (ALIGN_EPI) { if (wr == 1) PG8_BAR; }
    }
    PG8_WAIT_V(0);
    if constexpr (!ALIGN_EPI) { if (wr == 0) PG8_BAR; }
    PG8_BAR;
    if constexpr (Epi::AFTER_DRAIN) { E.fused(acc, cur, wr, wc, fr, fq, lds, wid, lane); S.done(cur); }
#undef PG8_SA
#undef PG8_SB
#undef PG8_STAGE
#undef PG8_LDA
#undef PG8_LDB
#undef PG8_MMA
#undef PG8_WAIT_V
#undef PG8_WAIT_L
#undef PG8_BAR
#undef PG8_SCHED
}
}

namespace pg8 {
struct EpiStore {
    static constexpr bool PERM = true, AFTER_DRAIN = false;
    bf16_t* O; int ldc;
    __device__ __forceinline__ void operator()(const f32x4 (&acc)[2][2][4][2], const Unit& u, int wr, int wc, int fr, int fq) const {
        const int row0 = u.pm * BM + wr * 64 + fr; const int col0 = u.pn * BM + wc * 32 + 8 * fq;
#pragma unroll
        for (int ai = 0; ai < 2; ++ai)
#pragma unroll
            for (int m = 0; m < 4; ++m) { bf16_t* rowp = O + (size_t)(row0 + ai * HALF + m * 16) * ldc + col0;
#pragma unroll
                for (int bj = 0; bj < 2; ++bj) { const f32x4 v0 = acc[ai][bj][m][0], v1 = acc[ai][bj][m][1];
                    u32x4 w; w.x = cvt_pk_bf16(v0[0], v0[1]); w.y = cvt_pk_bf16(v0[2], v0[3]); w.z = cvt_pk_bf16(v1[0], v1[1]); w.w = cvt_pk_bf16(v1[2], v1[3]);
                    *(u32x4*)(rowp + bj * HALF) = w; } }
    }
};
struct EpiSwiglu {
    static constexpr bool PERM = true, AFTER_DRAIN = false;
    bf16_t* O; int ldc;
    __device__ __forceinline__ void operator()(const f32x4 (&acc)[2][2][4][2], const Unit& u, int wr, int wc, int fr, int fq) const {
        const int row0 = u.pm * BM + wr * 64 + fr; const int col0 = u.pn * HALF + wc * 32 + 8 * fq;
#pragma unroll
        for (int ai = 0; ai < 2; ++ai)
#pragma unroll
            for (int m = 0; m < 4; ++m) { bf16_t* rowp = O + (size_t)(row0 + ai * HALF + m * 16) * ldc + col0;
                float h[8];
#pragma unroll
                for (int n = 0; n < 2; ++n)
#pragma unroll
                    for (int i = 0; i < 4; ++i) { const float g = acc[ai][0][m][n][i], up = acc[ai][1][m][n][i]; h[n * 4 + i] = g * __builtin_amdgcn_rcpf(1.f + __expf(-g)) * up; }
                u32x4 w; w.x = cvt_pk_bf16(h[0], h[1]); w.y = cvt_pk_bf16(h[2], h[3]); w.z = cvt_pk_bf16(h[4], h[5]); w.w = cvt_pk_bf16(h[6], h[7]);
                *(u32x4*)rowp = w; }
    }
};
}

using pg8::bf16_t; using pg8::bf16x8; using pg8::f32x4; using pg8::u32x4;
typedef float f32x16 __attribute__((ext_vector_type(16)));
typedef unsigned u32x2 __attribute__((ext_vector_type(2)));
#define DI __device__ __forceinline__
#define LDSFENCE() asm volatile("s_waitcnt lgkmcnt(0)" ::: "memory")
#define MFMA16(a, b, c) __builtin_amdgcn_mfma_f32_16x16x32_bf16((a), (b), (c), 0, 0, 0)
#define MFMA32(a, b, c) __builtin_amdgcn_mfma_f32_32x32x16_bf16((a), (b), (c), 0, 0, 0)

constexpr int DM = 1024, NB = 8, SL = 4096, NC = 256, TT = SL + NC, MR = NB * TT, DEPTH = 4;
constexpr int DIN = 2320, DINP = 2304, DFF = 2816;
constexpr int NCH = TT / 64, NCH32 = TT / 32;
constexpr int C_AQ = 0, C_AK = 512, C_AV = 640, C_MQ = 768, C_MK = 1024, C_MV = 1280, C_MO = 1536, C_RX = 1792, C_RY = 2048;
constexpr int MIX_ATT = 0, MIX_M = 512, MIX_R = 768;
constexpr float EPS = 1e-6f;
constexpr int NTHR = 512;
constexpr int RG = 5;
constexpr int LDS_BYTES = 147456;

constexpr size_t MiB = 1u << 20;
constexpr size_t WS_WIN = 0, WS_WOUT = 18 * MiB, WS_WF1 = 26 * MiB, WS_WF2 = 70 * MiB;
constexpr size_t WS_MOD = 92 * MiB, WS_ROPE = 93 * MiB, WS_LW = 93 * MiB + 512 * 1024, WS_GS = 94 * MiB, WS_MS = 94 * MiB + 256 * 1024, WS_M0 = 94 * MiB + 512 * 1024;
constexpr size_t WS_NLOC = 95 * MiB, WS_N0 = 97 * MiB, WS_LAGG = 99 * MiB, WS_CARRY = 104 * MiB, WS_GATES = 107 * MiB, WS_XC = 110 * MiB, WS_BAR = 119 * MiB;
constexpr size_t WS_ACT = 120 * MiB, WS_Y = 188 * MiB, WS_C0 = WS_Y, WS_CLOC = 256 * MiB, WS_P = 324 * MiB, WS_END = 511 * MiB;

struct Params {
    const float *x, *c, *ctx, *c_ctx, *w_ada, *b_ada, *norm_gain, *w_in, *w_out, *attn_sink, *mgate_b, *mnorm, *conv_w, *conv_b, *lru_w, *lru_b, *lru_lam, *w_f1, *w_f2;
    float* out; unsigned char* ws; int ph_lo, ph_hi;
};

DI float bf2f(unsigned short v) { return __uint_as_float((unsigned)v << 16); }
DI unsigned short f2bf(float f) { unsigned u = __float_as_uint(f); return (unsigned short)((u + 0x7fffu + ((u >> 16) & 1u)) >> 16); }
typedef __bf16 bf16x2_hw __attribute__((ext_vector_type(2)));
typedef float f32x2_hw __attribute__((ext_vector_type(2)));
DI unsigned pk2(float lo, float hi) { const f32x2_hw v = {lo, hi}; const bf16x2_hw b = __builtin_convertvector(v, bf16x2_hw); return __builtin_bit_cast(unsigned, b); }
DI void unpack8(const u32x4& v, float* f) {
    f[0] = __uint_as_float(v.x << 16); f[1] = __uint_as_float(v.x & 0xffff0000u); f[2] = __uint_as_float(v.y << 16); f[3] = __uint_as_float(v.y & 0xffff0000u);
    f[4] = __uint_as_float(v.z << 16); f[5] = __uint_as_float(v.z & 0xffff0000u); f[6] = __uint_as_float(v.w << 16); f[7] = __uint_as_float(v.w & 0xffff0000u);
}
DI u32x4 pack8(const float* f) { u32x4 w; w.x = pk2(f[0], f[1]); w.y = pk2(f[2], f[3]); w.z = pk2(f[4], f[5]); w.w = pk2(f[6], f[7]); return w; }
DI float wsum(float v) {
#pragma unroll
    for (int o = 32; o; o >>= 1) v += __shfl_xor(v, o);
    return v;
}
DI float wmaxf(float v) {
#pragma unroll
    for (int o = 32; o; o >>= 1) v = fmaxf(v, __shfl_xor(v, o));
    return v;
}
DI float frcp(float x) { return __builtin_amdgcn_rcpf(x); }
DI float sigmoidf_(float x) { return frcp(1.f + __expf(-x)); }
DI float logsigmoidf_(float x) { return fminf(x, 0.f) - log1pf(__expf(-fabsf(x))); }
DI float softplusf_(float x) { return fmaxf(x, 0.f) + log1pf(__expf(-fabsf(x))); }
DI float gelu_tanh(float y) { const float z = 0.7978845608028654f * (y + 0.044715f * y * y * y); const float th = 1.f - 2.f * frcp(__expf(2.f * z) + 1.f); return 0.5f * y * (1.f + th); }
DI float neg_expm1(float x) { const float pl = -x * (1.f + x * (0.5f + x * (0.16666667f + x * (0.041666668f + x * 0.008333334f)))); const float ex = 1.f - __expf(x); return x > -0.25f ? pl : ex; }
DI int crow(int reg, int h) { return (reg & 3) + 8 * (reg >> 2) + 4 * h; }

DI void transpose_tile(const float* src, int ldw, int k0, int srccol0, bf16_t* dst, int ldk, int dstrow0, float* tile) {
    int tid_l = threadIdx.x; asm volatile("" : "+v"(tid_l)); const int tid = tid_l;
    __syncthreads();
#pragma unroll
    for (int i = 0; i < 8; ++i) { const int kk = (tid >> 6) + 8 * i, nn = tid & 63; tile[kk * 65 + nn] = __builtin_nontemporal_load(&src[(size_t)(k0 + kk) * ldw + srccol0 + nn]); }
    __syncthreads();
    const int nn = tid >> 3, kg = tid & 7; float f[8];
#pragma unroll
    for (int j = 0; j < 8; ++j) f[j] = tile[(kg * 8 + j) * 65 + nn];
    *(u32x4*)(dst + (size_t)(dstrow0 + nn) * ldk + k0 + kg * 8) = pack8(f);
}

DI void convert_layer(const Params& p, unsigned char* lds, int l, int first, int nblk) {
    unsigned char* ws = p.ws; asm volatile("" : "+s"(ws));
    float* ldsf = (float*)lds;
    bf16_t* WIN = (bf16_t*)(ws + WS_WIN); bf16_t* WOUT = (bf16_t*)(ws + WS_WOUT); bf16_t* WF1 = (bf16_t*)(ws + WS_WF1); bf16_t* WF2 = (bf16_t*)(ws + WS_WF2);
    const int me = (int)blockIdx.x - first; if (me < 0) return;
    for (int it = me; it < 2944; it += nblk) {
        int rem = it;
        if (rem < 576) { const int kt = rem / 36, nt = rem % 36, dr = nt * 64, sc = dr < 1792 ? dr : dr + 16;
            transpose_tile(p.w_in + (size_t)l * 1024 * DIN, DIN, kt * 64, sc, WIN + (size_t)l * DINP * 1024, 1024, dr, ldsf); }
        else if (rem < 832) { rem -= 576; const int kt = rem / 16, nt = rem % 16;
            transpose_tile(p.w_out + (size_t)l * 1024 * 1024, 1024, kt * 64, nt * 64, WOUT + (size_t)l * 1024 * 1024, 1024, nt * 64, ldsf); }
        else if (rem < 2240) { rem -= 832; const int kt = rem / 88, nt = rem % 88, dr = nt * 64, tl = dr / 256, wi = dr % 256, sc = wi < 128 ? tl * 128 + wi : DFF + tl * 128 + wi - 128;
            transpose_tile(p.w_f1 + (size_t)l * 1024 * 2 * DFF, 2 * DFF, kt * 64, sc, WF1 + (size_t)l * 2 * DFF * 1024, 1024, dr, ldsf); }
        else { rem -= 2240; const int kt = rem / 16, nt = rem % 16;
            transpose_tile(p.w_f2 + (size_t)l * DFF * 1024, 1024, kt * 64, nt * 64, WF2 + (size_t)l * 1024 * DFF, DFF, nt * 64, ldsf); }
    }
}

DI void phase_setup(const Params& p, unsigned char* lds) {
    int tid_l = threadIdx.x; asm volatile("" : "+v"(tid_l)); const int tid = tid_l, G = gridDim.x, bid = blockIdx.x;
    unsigned char* ws = p.ws; asm volatile("" : "+s"(ws));
    float* ldsf = (float*)lds;
    {
        float* sl = ldsf;
        float* red = ldsf + 9 * 1024;
        for (int i = tid; i < 9 * 1024; i += NTHR) { const int bb = i >> 10, k = i & 1023; const float v = bb < 8 ? p.c[bb * 1024 + k] : p.c_ctx[k]; sl[i] = v / (1.f + __expf(-v)); }
        __syncthreads();
        float* MOD = (float*)(ws + WS_MOD);
        for (int it = bid; it < 4 * 192; it += G) {
            const int l = it / 192, n0 = (it % 192) * 32, cc = tid & 31, kg = tid >> 5;
            float acc[9];
#pragma unroll
            for (int bb = 0; bb < 9; ++bb) acc[bb] = 0.f;
            const float* wp = p.w_ada + ((size_t)l * 1024 + kg * 64) * 6144 + n0 + cc;
#pragma unroll 1
            for (int k0 = 0; k0 < 64; k0 += 16) { float w[16];
#pragma unroll
                for (int k = 0; k < 16; ++k) w[k] = __builtin_nontemporal_load(&wp[(size_t)(k0 + k) * 6144]);
#pragma unroll
                for (int k = 0; k < 16; ++k)
#pragma unroll
                    for (int bb = 0; bb < 9; ++bb) acc[bb] += sl[bb * 1024 + kg * 64 + k0 + k] * w[k]; }
#pragma unroll
            for (int bb = 0; bb < 9; ++bb) red[(kg * 9 + bb) * 32 + cc] = acc[bb];
            __syncthreads();
            if (tid < 288) { const int bb = tid >> 5; float s = p.b_ada[l * 6144 + n0 + cc];
                for (int q = 0; q < 16; ++q) s += red[(q * 9 + bb) * 32 + cc];
                const int ci = n0 >> 10, col = (n0 & 1023) + cc; const float* ng = p.norm_gain + (size_t)l * 4 * 1024;
                if (ci == 1) s = ng[col] * (1.f + s); else if (ci == 2) s = s * ng[1024 + col]; else if (ci == 4) s = ng[2048 + col] * (1.f + s); else if (ci == 5) s = s * ng[3072 + col];
                MOD[((size_t)l * 9 + bb) * 6144 + n0 + cc] = s; }
            __syncthreads();
        }
    }
    convert_layer(p, lds, 0, 0, G);
    {
        bf16_t* LW = (bf16_t*)(ws + WS_LW);
        for (int m = bid; m < 64; m += G) transpose_tile(p.lru_w + (size_t)m * 4096, 64, 0, 0, LW + (size_t)m * 4096, 64, 0, ldsf);
    }
    if (bid == G - 1) {
        float* ROPE = (float*)(ws + WS_ROPE);
        for (int i = tid; i < 1024; i += NTHR) { const int pos = i >> 4, fi = i & 15; const float fr = exp2f(-(float)fi * (13.287712379549449f / 16.f)); const float ang = (float)pos * fr;
            const float n = rintf(ang * 0.15915494309189535f); float r = fmaf(-n, 6.28125f, ang); r = fmaf(-n, 1.9353071795864769e-3f, r);
            ROPE[2 * i] = cosf(r); ROPE[2 * i + 1] = sinf(r); }
    }
}

DI void phase_rows(const Params& p, unsigned char* lds, int l, int kind, float brs = 1.f) {
    int tid_l = threadIdx.x; asm volatile("" : "+v"(tid_l)); const int tid = tid_l, lane = tid & 63, wave = __builtin_amdgcn_readfirstlane(tid >> 6);
    unsigned char* ws = p.ws; asm volatile("" : "+s"(ws));
    const float* MOD = (const float*)(ws + WS_MOD);
    bf16_t* ACT = (bf16_t*)(ws + WS_ACT); const bf16_t* Y = (const bf16_t*)(ws + WS_Y); float* XC = (float*)(ws + WS_XC); float* GATES = (float*)(ws + WS_GATES);
    float* wgT = (float*)lds;
    const bool src_in = (l == 0 && kind <= 1);
    const bool has_br = !(kind == 0 && l == 0);
    const int lb = (kind == 0) ? l - 1 : l;
    const int gi_br = (kind == 1) ? 1 : 3, mi_br = (kind == 1) ? 2 : 5;
    const int gi_pre = (kind == 0) ? 0 : 2, mi_sh = (kind == 0) ? 0 : 3;
    __syncthreads();
    if (kind == 0) {
        const float* wsrc = p.w_in + (size_t)l * 1024 * DIN + 1792;
        for (int i = tid; i < 16384; i += NTHR) { const int k = i >> 4, j = i & 15; wgT[j * 1028 + k] = wsrc[(size_t)k * DIN + j]; }
        __syncthreads();
    }
    const int wg = blockIdx.x * 8 + wave, nwv = gridDim.x * 8;
#pragma unroll 1
    for (int r0 = wg; r0 < MR; r0 += RG * nwv) {
        int rr_[RG]; bool ok[RG]; size_t xoff[RG]; bool isc[RG]; int bb[RG];
        float xv[RG][4][4]; u32x2 yraw[RG][4];
#pragma unroll
        for (int q = 0; q < RG; ++q) {
            int r = r0 + q * nwv; ok[q] = r < MR; if (!ok[q]) r = r0;
            const int b = r / TT, t = r - b * TT; isc[q] = t < NC; bb[q] = isc[q] ? 8 : b; rr_[q] = r;
            if ((kind == 2 || (kind == 1 && l == DEPTH - 1)) && isc[q]) ok[q] = false;
            xoff[q] = isc[q] ? ((size_t)b * NC + t) * DM : ((size_t)b * SL + (t - NC)) * DM;
            const float* xs = src_in ? (isc[q] ? p.ctx + xoff[q] : p.x + xoff[q]) : (isc[q] ? XC + xoff[q] : p.out + xoff[q]);
#pragma unroll
            for (int i = 0; i < 4; ++i) { const f32x4 v = __builtin_nontemporal_load((const f32x4*)(xs + 4 * lane + 256 * i)); xv[q][i][0] = v.x; xv[q][i][1] = v.y; xv[q][i][2] = v.z; xv[q][i][3] = v.w; }
            if (has_br) { const bf16_t* yr = Y + (size_t)r * DM;
#pragma unroll
                for (int i = 0; i < 4; ++i) yraw[q][i] = __builtin_nontemporal_load((const u32x2*)(yr + 4 * lane + 256 * i)); }
        }
#pragma unroll
        for (int q = 0; q < RG; ++q) {
            const int r = rr_[q];
            if (has_br) {
                float yv[4][4]; float ss = 0.f;
#pragma unroll
                for (int i = 0; i < 4; ++i) { const u32x2 v = yraw[q][i];
                    yv[i][0] = __uint_as_float(v.x << 16); yv[i][1] = __uint_as_float(v.x & 0xffff0000u); yv[i][2] = __uint_as_float(v.y << 16); yv[i][3] = __uint_as_float(v.y & 0xffff0000u);
#pragma unroll
                    for (int c = 0; c < 4; ++c) ss += yv[i][c] * yv[i][c]; }
                ss = wsum(ss); const float rs = brs * rsqrtf(ss * (1.f / 1024.f) + EPS);
                const float* gate = MOD + ((size_t)(lb * 9 + bb[q]) * 6 + mi_br) * 1024;
                float* xd = isc[q] ? XC + xoff[q] : p.out + xoff[q];
#pragma unroll
                for (int i = 0; i < 4; ++i) { const float4 mv = *(const float4*)(gate + 4 * lane + 256 * i);
                    xv[q][i][0] += mv.x * (yv[i][0] * rs); xv[q][i][1] += mv.y * (yv[i][1] * rs); xv[q][i][2] += mv.z * (yv[i][2] * rs); xv[q][i][3] += mv.w * (yv[i][3] * rs);
                    if (ok[q]) __builtin_nontemporal_store((f32x4){xv[q][i][0], xv[q][i][1], xv[q][i][2], xv[q][i][3]}, (f32x4*)(xd + 4 * lane + 256 * i)); }
            }
            if (kind != 2) {
                float ss = 0.f;
#pragma unroll
                for (int i = 0; i < 4; ++i)
#pragma unroll
                    for (int c = 0; c < 4; ++c) ss += xv[q][i][c] * xv[q][i][c];
                ss = wsum(ss); const float rs = rsqrtf(ss * (1.f / 1024.f) + EPS);
                const float* sh = MOD + ((size_t)(l * 9 + bb[q]) * 6 + mi_sh) * 1024; const float* sc = sh + 1024;
                float hv[4][4];
#pragma unroll
                for (int i = 0; i < 4; ++i) { const float4 sv = *(const float4*)(sh + 4 * lane + 256 * i); const float4 cv = *(const float4*)(sc + 4 * lane + 256 * i);
                    hv[i][0] = xv[q][i][0] * rs * cv.x + sv.x; hv[i][1] = xv[q][i][1] * rs * cv.y + sv.y; hv[i][2] = xv[q][i][2] * rs * cv.z + sv.z; hv[i][3] = xv[q][i][3] * rs * cv.w + sv.w;
                    u32x2 o; o.x = pk2(hv[i][0], hv[i][1]); o.y = pk2(hv[i][2], hv[i][3]); if (ok[q]) *(u32x2*)(ACT + (size_t)r * DM + 4 * lane + 256 * i) = o; }
                if (kind == 0) {
#pragma unroll
                    for (int i = 0; i < 4; ++i)
#pragma unroll
                        for (int c = 0; c < 4; ++c) xv[q][i][c] = hv[i][c];
                }
            }
        }
        if (kind == 0) {
#pragma unroll 1
            for (int j0 = 0; j0 < 4; ++j0) {
                float a[RG][4];
#pragma unroll
                for (int q = 0; q < RG; ++q)
#pragma unroll
                    for (int jj = 0; jj < 4; ++jj) a[q][jj] = 0.f;
#pragma unroll
                for (int jj = 0; jj < 4; ++jj)
#pragma unroll
                    for (int i = 0; i < 4; ++i) { const float4 w = *(const float4*)(wgT + (4 * j0 + jj) * 1028 + 4 * lane + 256 * i);
#pragma unroll
                        for (int q = 0; q < RG; ++q) a[q][jj] += xv[q][i][0] * w.x + xv[q][i][1] * w.y + xv[q][i][2] * w.z + xv[q][i][3] * w.w; }
#pragma unroll
                for (int q = 0; q < RG; ++q) {
                    { const bool hi = (lane & 32) != 0;
#pragma unroll
                      for (int i = 0; i < 2; ++i) { const float send = hi ? a[q][i] : a[q][i + 2], keep = hi ? a[q][i + 2] : a[q][i]; a[q][i] = keep + __shfl_xor(send, 32); } }
                    { const bool hi = (lane & 16) != 0; const float send = hi ? a[q][0] : a[q][1], keep = hi ? a[q][1] : a[q][0]; a[q][0] = keep + __shfl_xor(send, 16); }
                    a[q][0] += __shfl_xor(a[q][0], 8); a[q][0] += __shfl_xor(a[q][0], 4); a[q][0] += __shfl_xor(a[q][0], 2); a[q][0] += __shfl_xor(a[q][0], 1);
                    if (ok[q] && (lane & 15) == 0) GATES[(size_t)rr_[q] * 16 + 4 * j0 + (lane >> 4)] = a[q][0];
                }
            }
        }
    }
}

DI void attn_unit(const Params& p, unsigned char* lds, int l, int b, int qb64, int kvh, bool isctx) {
    int tid_l = threadIdx.x; asm volatile("" : "+v"(tid_l)); const int tid = tid_l, lane = tid & 63, wave = __builtin_amdgcn_readfirstlane(tid >> 6);
    const int g = wave >> 1, half = wave & 1, head = kvh * 4 + g, hh = lane >> 5, ql = lane & 31;
    unsigned char* ws = p.ws; asm volatile("" : "+s"(ws));
    const bf16_t* P = (const bf16_t*)(ws + WS_P); bf16_t* MIX = (bf16_t*)(ws + WS_ACT); const float* rope = (const float*)(ws + WS_ROPE);
    bf16_t* Ks = (bf16_t*)lds;
    bf16_t* Vt = (bf16_t*)(lds + 18432);
    const size_t rowb = (size_t)b * TT;
    const int qpos = qb64 * 64 + half * 32 + ql;
    const int tq = (isctx ? 0 : NC) + qpos;
    const int kb0 = qb64 >> 1;
    constexpr float LOG2E = 1.4426950408889634f;
    bf16x8 qf[4];
    {
        const bf16_t* qp = P + (rowb + tq) * DINP + C_AQ + head * 64 + 8 * hh;
        float f[4][8];
#pragma unroll
        for (int kk = 0; kk < 4; ++kk) { const u32x4 raw = __builtin_nontemporal_load((const u32x4*)(qp + 16 * kk)); unpack8(raw, f[kk]); }
        if (!isctx) { const int rr = qpos >> 6, cc = qpos & 63;
#pragma unroll
            for (int j = 0; j < 8; ++j) { const int i = 8 * hh + j; const float2 r1 = *(const float2*)(rope + (rr * 16 + i) * 2), r2 = *(const float2*)(rope + (cc * 16 + i) * 2);
                float x1 = f[0][j], x2 = f[1][j]; f[0][j] = x1 * r1.x - x2 * r1.y; f[1][j] = x2 * r1.x + x1 * r1.y;
                x1 = f[2][j]; x2 = f[3][j]; f[2][j] = x1 * r2.x - x2 * r2.y; f[3][j] = x2 * r2.x + x1 * r2.y; } }
#pragma unroll
        for (int kk = 0; kk < 4; ++kk) {
#pragma unroll
            for (int j = 0; j < 8; ++j) f[kk][j] *= 0.125f * LOG2E;
            qf[kk] = __builtin_bit_cast(bf16x8, pack8(f[kk])); }
    }
    const float sink = p.attn_sink[l * 8 + head] * LOG2E;
    float mrun = sink, lsum = hh == 0 ? 1.f : 0.f;
    f32x16 O[2];
#pragma unroll
    for (int c = 0; c < 2; ++c)
#pragma unroll
        for (int i = 0; i < 16; ++i) O[c][i] = 0.f;

    const int skey = tid >> 2, spart = tid & 3, sc = (spart & 1) + (spart >> 1) * 4;
    u32x4 pra, prb, pv0, pv1;
    int ti = 0;
#define ATT_TILE_ROW(ti_) ((ti_) < 2 ? (ti_) * 128 : NC + (kb0 + (ti_) - 3) * 128)
#define ATT_LOAD(ti_) do { const bf16_t* kp_ = P + (rowb + ATT_TILE_ROW(ti_) + skey) * DINP + C_AK + kvh * 64; pra = *(const u32x4*)(kp_ + 8 * sc); prb = *(const u32x4*)(kp_ + 8 * (sc + 2)); \
        const bf16_t* vp_ = P + (rowb + ATT_TILE_ROW(ti_) + skey) * DINP + C_AV + kvh * 64 + spart * 16; pv0 = *(const u32x4*)vp_; pv1 = *(const u32x4*)(vp_ + 8); } while (0)
    ATT_LOAD(0);
#pragma unroll 1
    while (ti < 5) {
        const bool kctx = ti < 2; const int kb = kb0 + ti - 3; const int kt0 = ATT_TILE_ROW(ti);
        int tn = ti + 1;
        if (isctx) { if (tn >= 2) tn = 5; } else { if (tn == 2 && kb0 == 0) tn = 3; if (tn == 4 && kb0 == 31) tn = 5; }
        __syncthreads();
        {
            u32x4 ra = pra, rb = prb;
            if (!kctx) { float fa[8], fb[8]; unpack8(ra, fa); unpack8(rb, fb); const int pos = kt0 - NC + skey, tp = sc < 2 ? pos >> 6 : pos & 63, ib = 8 * (sc & 1);
#pragma unroll
                for (int j = 0; j < 8; ++j) { const float2 cs = *(const float2*)(rope + (tp * 16 + ib + j) * 2); const float x1 = fa[j], x2 = fb[j]; fa[j] = x1 * cs.x - x2 * cs.y; fb[j] = x2 * cs.x + x1 * cs.y; }
                ra = pack8(fa); rb = pack8(fb); }
            *(u32x4*)(Ks + skey * 72 + 8 * sc) = ra; *(u32x4*)(Ks + skey * 72 + 8 * (sc + 2)) = rb;
            const unsigned vv[8] = {pv0.x, pv0.y, pv0.z, pv0.w, pv1.x, pv1.y, pv1.z, pv1.w};
#pragma unroll
            for (int e = 0; e < 8; ++e) { Vt[(spart * 16 + 2 * e) * 136 + skey] = (bf16_t)(vv[e] & 0xffffu); Vt[(spart * 16 + 2 * e + 1) * 136 + skey] = (bf16_t)(vv[e] >> 16); }
        }
        if (tn < 5) ATT_LOAD(tn);
        __syncthreads();
        const bool domask = (!kctx) && (ti != 3);
        int k2lo = 0, k2hi = 2;
        if (!kctx) { if (ti == 2 && (qb64 & 1)) k2lo = 1; if (ti == 4 && !(qb64 & 1)) k2hi = 1; }
#pragma unroll 1
        for (int k2 = k2lo; k2 < k2hi; ++k2) {
            f32x16 s[2];
#pragma unroll
            for (int ks = 0; ks < 2; ++ks) {
#pragma unroll
                for (int i = 0; i < 16; ++i) s[ks][i] = 0.f;
#pragma unroll
                for (int kk = 0; kk < 4; ++kk) { const bf16x8 ka = *(const bf16x8*)(Ks + (64 * k2 + 32 * ks + ql) * 72 + 16 * kk + 8 * hh); s[ks] = MFMA32(ka, qf[kk], s[ks]); }
            }
            if (domask) {
#pragma unroll
                for (int ks = 0; ks < 2; ++ks)
#pragma unroll
                    for (int i = 0; i < 16; ++i) { const int kpos = kb * 128 + 64 * k2 + 32 * ks + crow(i, hh); const int dd = qpos - kpos; if (dd > 128 || dd < -128) s[ks][i] = -INFINITY; } }
            float tmax = fmaxf(s[0][0], s[1][0]);
#pragma unroll
            for (int i = 1; i < 16; ++i) tmax = fmaxf(tmax, fmaxf(s[0][i], s[1][i]));
            tmax = fmaxf(tmax, __shfl_xor(tmax, 32));
            const float mnew = fmaxf(mrun, tmax), alpha = __builtin_amdgcn_exp2f(mrun - mnew); mrun = mnew;
            float psum = 0.f;
#pragma unroll
            for (int ks = 0; ks < 2; ++ks)
#pragma unroll
                for (int i = 0; i < 16; ++i) { s[ks][i] = __builtin_amdgcn_exp2f(s[ks][i] - mnew); psum += s[ks][i]; }
            lsum = lsum * alpha + psum;
#pragma unroll
            for (int dt = 0; dt < 2; ++dt)
#pragma unroll
                for (int i = 0; i < 16; ++i) O[dt][i] *= alpha;
#pragma unroll
            for (int ks = 0; ks < 2; ++ks)
#pragma unroll
                for (int st = 0; st < 2; ++st) {
                    u32x4 pw; pw.x = pk2(s[ks][8 * st], s[ks][8 * st + 1]); pw.y = pk2(s[ks][8 * st + 2], s[ks][8 * st + 3]); pw.z = pk2(s[ks][8 * st + 4], s[ks][8 * st + 5]); pw.w = pk2(s[ks][8 * st + 6], s[ks][8 * st + 7]);
                    const bf16x8 pb = __builtin_bit_cast(bf16x8, pw);
#pragma unroll
                    for (int dt = 0; dt < 2; ++dt) { const bf16_t* vr = Vt + (32 * dt + ql) * 136 + 64 * k2 + 32 * ks + 16 * st + 4 * hh;
                        const u32x2 a0 = *(const u32x2*)vr, a1 = *(const u32x2*)(vr + 8); u32x4 aw; aw.x = a0.x; aw.y = a0.y; aw.z = a1.x; aw.w = a1.y;
                        O[dt] = MFMA32(__builtin_bit_cast(bf16x8, aw), pb, O[dt]); }
                }
        }
        ti = tn;
    }
#undef ATT_LOAD
#undef ATT_TILE_ROW
    {
        const float ltot = lsum + __shfl_xor(lsum, 32), inv = frcp(ltot);
        bf16_t* op = MIX + (rowb + tq) * DM + MIX_ATT + head * 64;
#pragma unroll
        for (int dt = 0; dt < 2; ++dt)
#pragma unroll
            for (int g4 = 0; g4 < 4; ++g4) { u32x2 o; o.x = pk2(O[dt][4 * g4] * inv, O[dt][4 * g4 + 1] * inv); o.y = pk2(O[dt][4 * g4 + 2] * inv, O[dt][4 * g4 + 3] * inv);
                *(u32x2*)(op + 32 * dt + 8 * g4 + 4 * hh) = o; }
    }
}

DI void stage_rows(const bf16_t* src, bf16_t* dst) {
    int tid_l = threadIdx.x; asm volatile("" : "+v"(tid_l)); const int tid = tid_l;
#pragma unroll
    for (int it = 0; it < 4; ++it) { const int idx = tid + it * NTHR, t = idx >> 5, cg = idx & 31; *(u32x4*)(dst + t * 264 + 8 * cg) = *(const u32x4*)(src + (size_t)t * DINP + 8 * cg); }
}
DI void stage_transposed(const bf16_t* src, bf16_t* dst) {
    int tid_l = threadIdx.x; asm volatile("" : "+v"(tid_l)); const int tid = tid_l;
#pragma unroll
    for (int it = 0; it < 4; ++it) { const int idx = tid + it * NTHR, t = idx & 63, cg = idx >> 6; const u32x4 v = *(const u32x4*)(src + (size_t)t * DINP + 8 * cg);
        const unsigned vv[4] = {v.x, v.y, v.z, v.w};
#pragma unroll
        for (int e = 0; e < 4; ++e) { dst[(8 * cg + 2 * e) * 72 + t] = (bf16_t)(vv[e] & 0xffffu); dst[(8 * cg + 2 * e + 1) * 72 + t] = (bf16_t)(vv[e] >> 16); } }
#pragma unroll
    for (int it = 0; it < 2; ++it) { const int idx = tid + it * NTHR; dst[(256 + (idx >> 6)) * 72 + (idx & 63)] = (bf16_t)0x3F80; }
}
DI float prefix_sum(float v, int lane) {
#pragma unroll
    for (int o = 1; o < 64; o <<= 1) { const float u = __shfl_up(v, o); if (lane >= o) v += u; }
    return v;
}
DI float prefix_max(float v, int lane) {
#pragma unroll
    for (int o = 1; o < 64; o <<= 1) { const float u = __shfl_up(v, o); if (lane >= o) v = fmaxf(v, u); }
    return v;
}

DI void mlstm_local_unit(const Params& p, unsigned char* lds, int l, int b, int c) {
    int tid_l = threadIdx.x; asm volatile("" : "+v"(tid_l)); const int tid = tid_l, lane = tid & 63, wave = __builtin_amdgcn_readfirstlane(tid >> 6), h = wave & 3, d = wave >> 2, fr = lane & 15, fq = lane >> 4;
    unsigned char* ws = p.ws; asm volatile("" : "+s"(ws));
    const bf16_t* P = (const bf16_t*)(ws + WS_P); const float* GATES = (const float*)(ws + WS_GATES);
    float* GS = (float*)(ws + WS_GS); float* MS = (float*)(ws + WS_MS); float* CLOC = (float*)(ws + WS_CLOC); float* NLOC = (float*)(ws + WS_NLOC);
    bf16_t* Kt = (bf16_t*)lds;
    bf16_t* Vt = (bf16_t*)(lds + 36864);
    float* wl = (float*)(lds + 76032) + wave * 64;
    const size_t row0 = (size_t)b * TT + c * 64;
    __syncthreads();
    stage_transposed(P + row0 * DINP + C_MK, Kt);
    stage_transposed(P + row0 * DINP + C_MV, Vt);
    const int tau = d ? 63 - lane : lane;
    const float* G = GATES + (row0 + tau) * 16; const float* gb = p.mgate_b + l * 16;
    const float li = G[(2 * d) * 4 + h] + gb[(2 * d) * 4 + h]; const float lf = logsigmoidf_(G[(2 * d + 1) * 4 + h] + gb[(2 * d + 1) * 4 + h]);
    const float bc = prefix_sum(lf, lane); const float gt = __shfl(bc, 63); const float a = gt - bc + li; const float ml = wmaxf(a); const float w = __expf(a - ml);
    wl[tau] = w;
    const int nd = d ? (c < 4 ? 3 - c : 71 - c) : c; const int sid = (b * 4 + h) * 2 + d;
    if (lane == 0) { GS[sid * NCH + nd] = gt; MS[sid * NCH + nd] = ml; }
    __syncthreads();
    bf16x8 va[4][2];
#pragma unroll
    for (int et = 0; et < 4; ++et)
#pragma unroll
        for (int kk = 0; kk < 2; ++kk) va[et][kk] = *(const bf16x8*)(Vt + (h * 64 + 16 * et + fr) * 72 + 32 * kk + 8 * fq);
    float* outp = CLOC + ((size_t)sid * NCH + nd) * 4096;
#pragma unroll
    for (int dt = 0; dt < 4; ++dt) {
        bf16x8 kb[2];
#pragma unroll
        for (int kk = 0; kk < 2; ++kk) { const u32x4 raw = *(const u32x4*)(Kt + (h * 64 + 16 * dt + fr) * 72 + 32 * kk + 8 * fq); float f[8]; unpack8(raw, f);
            const float4 w0 = *(const float4*)(wl + 32 * kk + 8 * fq), w1 = *(const float4*)(wl + 32 * kk + 8 * fq + 4);
            f[0] *= w0.x; f[1] *= w0.y; f[2] *= w0.z; f[3] *= w0.w; f[4] *= w1.x; f[5] *= w1.y; f[6] *= w1.z; f[7] *= w1.w;
            kb[kk] = __builtin_bit_cast(bf16x8, pack8(f)); }
#pragma unroll
        for (int et = 0; et < 4; ++et) { f32x4 acc = {0.f, 0.f, 0.f, 0.f};
#pragma unroll
            for (int kk = 0; kk < 2; ++kk) acc = MFMA16(va[et][kk], kb[kk], acc);
#pragma unroll
            for (int j = 0; j < 4; ++j) __builtin_nontemporal_store(acc[j] * 0.125f, &outp[(16 * et + 4 * fq + j) * 64 + 16 * dt + fr]); }
    }
    { float s = 0.f; const bf16_t* kr = Kt + (h * 64 + lane) * 72;
#pragma unroll
      for (int t8 = 0; t8 < 8; ++t8) { const u32x4 raw = *(const u32x4*)(kr + 8 * t8); float f[8]; unpack8(raw, f);
#pragma unroll
          for (int j = 0; j < 8; ++j) s += f[j] * wl[8 * t8 + j]; }
      NLOC[((size_t)sid * NCH + nd) * 64 + lane] = s * 0.125f; }
}

DI void mlstm_scan_unit(const Params& p, unsigned char* lds, int u) {
    int tid_l = threadIdx.x; asm volatile("" : "+v"(tid_l)); const int tid = tid_l, sid = u >> 3, slab = u & 7;
    unsigned char* ws = p.ws; asm volatile("" : "+s"(ws));
    const float* GS = (const float*)(ws + WS_GS); const float* MS = (const float*)(ws + WS_MS); float* M0 = (float*)(ws + WS_M0);
    const float* CLOC = (const float*)(ws + WS_CLOC); bf16_t* C0 = (bf16_t*)(ws + WS_C0); const float* NLOC = (const float*)(ws + WS_NLOC); float* N0 = (float*)(ws + WS_N0);
    float* fpv = (float*)lds; float* flv = fpv + 128;
    __syncthreads();
    float* gsv = fpv + 256; float* msv = fpv + 384; float* m0v = fpv + 512;
    if (tid < NCH) { gsv[tid] = GS[sid * NCH + tid]; msv[tid] = MS[sid * NCH + tid]; }
    __syncthreads();
    if (tid == 0) { float m = 0.f;
        for (int j = 0; j < NCH; ++j) { const float g = gsv[j], ml = msv[j]; const float mn = fmaxf(g + m, ml); fpv[j] = __expf(g + m - mn); flv[j] = __expf(ml - mn); m0v[j] = m; m = mn; } }
    __syncthreads();
    if (slab == 0 && tid < NCH) M0[sid * NCH + tid] = m0v[tid];
    { const float* src = CLOC + (size_t)sid * NCH * 4096 + slab * 512 + tid; bf16_t* dst = C0 + (size_t)sid * NCH * 4096 + slab * 512 + tid; float C = 0.f;
#pragma unroll 1
      for (int j0 = 0; j0 < NCH; j0 += 17) { float v[17];
#pragma unroll
          for (int k = 0; k < 17; ++k) v[k] = __builtin_nontemporal_load(&src[(size_t)(j0 + k) * 4096]);
#pragma unroll
          for (int k = 0; k < 17; ++k) { dst[(size_t)(j0 + k) * 4096] = f2bf(C); C = fpv[j0 + k] * C + flv[j0 + k] * v[k]; } } }
    if (slab == 0 && tid < 64) { const float* src = NLOC + (size_t)sid * NCH * 64 + tid; float* dst = N0 + (size_t)sid * NCH * 64 + tid; float C = 0.f;
        for (int j = 0; j < NCH; ++j) { const float v = src[j * 64]; dst[j * 64] = C; C = fpv[j] * C + flv[j] * v; } }
}

DI void mlstm_out_unit(const Params& p, unsigned char* lds, int l, int b, int c) {
    int tid_l = threadIdx.x; asm volatile("" : "+v"(tid_l)); const int tid = tid_l, lane = tid & 63, wave = __builtin_amdgcn_readfirstlane(tid >> 6), h = wave & 3, d = wave >> 2, fr = lane & 15, fq = lane >> 4;
    unsigned char* ws = p.ws; asm volatile("" : "+s"(ws));
    const bf16_t* P = (const bf16_t*)(ws + WS_P); bf16_t* MIX = (bf16_t*)(ws + WS_ACT); const float* GATES = (const float*)(ws + WS_GATES);
    const float* M0 = (const float*)(ws + WS_M0); const bf16_t* C0 = (const bf16_t*)(ws + WS_C0); const float* N0 = (const float*)(ws + WS_N0);
    bf16_t* Vt = (bf16_t*)lds;
    bf16_t* Sp = (bf16_t*)(lds + 39168) + wave * 1152;
    float* scal = (float*)(lds + 57600) + wave * 192;
    float* hbuf = (float*)(lds + 63744);
    const size_t row0 = (size_t)b * TT + c * 64;
    __syncthreads();
    stage_transposed(P + row0 * DINP + C_MV, Vt);
    for (int i = tid; i < 64 * 260; i += NTHR) hbuf[i] = 0.f;
    const int tau = d ? 63 - lane : lane;
    const float* G = GATES + (row0 + tau) * 16; const float* gb = p.mgate_b + l * 16;
    const float li = G[(2 * d) * 4 + h] + gb[(2 * d) * 4 + h]; const float lf = logsigmoidf_(G[(2 * d + 1) * 4 + h] + gb[(2 * d + 1) * 4 + h]);
    const float bc = prefix_sum(lf, lane); const float cs = li - bc; const float mx = prefix_max(cs, lane);
    const int nd = d ? (c < 4 ? 3 - c : 71 - c) : c; const int sid = (b * 4 + h) * 2 + d;
    const float m0 = M0[sid * NCH + nd]; const float mu = fmaxf(mx, m0);
    scal[tau] = cs; scal[64 + tau] = mu; scal[128 + tau] = bc;
    __syncthreads();
    const bf16_t* C0p = C0 + ((size_t)sid * NCH + nd) * 4096; const float* N0p = N0 + ((size_t)sid * NCH + nd) * 64;
    const bf16_t* Qg = P + row0 * DINP + C_MQ + h * 64 + 8 * fq; const bf16_t* Kg = P + row0 * DINP + C_MK + h * 64 + 8 * fq;
    bf16x8 kf[4][2], nf[2], qall[4][2], cfr[4][2];
#pragma unroll
    for (int kk = 0; kk < 2; ++kk) {
#pragma unroll
        for (int ns = 0; ns < 4; ++ns) { kf[ns][kk] = *(const bf16x8*)(Kg + (size_t)(16 * ns + fr) * DINP + 32 * kk); qall[ns][kk] = *(const bf16x8*)(Qg + (size_t)(16 * ns + fr) * DINP + 32 * kk);
            cfr[ns][kk] = *(const bf16x8*)(C0p + (16 * ns + fr) * 64 + 32 * kk + 8 * fq); }
        float f[8];
#pragma unroll
        for (int j = 0; j < 8; ++j) f[j] = N0p[32 * kk + 8 * fq + j];
        nf[kk] = __builtin_bit_cast(bf16x8, pack8(f));
    }
#pragma unroll
    for (int mt = 0; mt < 4; ++mt) {
        bf16x8 qa[2];
#pragma unroll
        for (int kk = 0; kk < 2; ++kk) qa[kk] = qall[mt][kk];
#pragma unroll
        for (int ns = 0; ns < 4; ++ns) { f32x4 s = {0.f, 0.f, 0.f, 0.f};
#pragma unroll
            for (int kk = 0; kk < 2; ++kk) s = MFMA16(qa[kk], kf[ns][kk], s);
            const int sx = 16 * ns + fr; const float csx = scal[sx];
#pragma unroll
            for (int j = 0; j < 4; ++j) { const int t = 16 * mt + 4 * fq + j; const bool ok = d ? (sx >= t) : (sx <= t); const float val = ok ? s[j] * 0.125f * __expf(csx - scal[64 + t]) : 0.f; Sp[(4 * fq + j) * 72 + sx] = f2bf(val); } }
        LDSFENCE();
        f32x4 aS[5], aI[5];
#pragma unroll
        for (int et = 0; et < 5; ++et) { aS[et] = (f32x4){0.f, 0.f, 0.f, 0.f}; aI[et] = (f32x4){0.f, 0.f, 0.f, 0.f}; }
#pragma unroll
        for (int kk = 0; kk < 2; ++kk) { const bf16x8 sa = *(const bf16x8*)(Sp + fr * 72 + 32 * kk + 8 * fq);
#pragma unroll
            for (int et = 0; et < 5; ++et) { const bf16x8 vf = *(const bf16x8*)(Vt + ((et < 4 ? h * 64 + 16 * et : 256) + fr) * 72 + 32 * kk + 8 * fq); aS[et] = MFMA16(sa, vf, aS[et]); }
#pragma unroll
            for (int et = 0; et < 4; ++et) aI[et] = MFMA16(qa[kk], cfr[et][kk], aI[et]);
            aI[4] = MFMA16(qa[kk], nf[kk], aI[4]); }
#pragma unroll
        for (int j = 0; j < 4; ++j) { const int t = 16 * mt + 4 * fq + j; const float mut = scal[64 + t]; const float fi = __expf(m0 - mut); const float den = fi * aI[4][j] + aS[4][j];
            const float lim = __expf(-scal[128 + t] - mut); const float inv = frcp(fmaxf(fabsf(den), lim));
#pragma unroll
            for (int et = 0; et < 4; ++et) atomicAdd(&hbuf[t * 260 + h * 64 + 16 * et + fr], (fi * aI[et][j] + aS[et][j]) * inv); }
        LDSFENCE();
    }
    __syncthreads();
    float ng[4];
#pragma unroll
    for (int h2 = 0; h2 < 4; ++h2) ng[h2] = p.mnorm[l * 256 + h2 * 64 + lane];
#pragma unroll 1
    for (int kb = 0; kb < 32; kb += 8) {
        float ov[8];
#pragma unroll
        for (int k = 0; k < 8; ++k) { const int t = wave * 8 + ((kb + k) >> 2), h2 = k & 3; ov[k] = bf2f(P[(row0 + t) * DINP + C_MO + h2 * 64 + lane]); }
#pragma unroll
        for (int k = 0; k < 8; ++k) { const int t = wave * 8 + ((kb + k) >> 2), h2 = k & 3; const float v = hbuf[t * 260 + h2 * 64 + lane];
            float s1 = v, s2 = v * v;
#pragma unroll
            for (int o = 32; o; o >>= 1) { s1 += __shfl_xor(s1, o); s2 += __shfl_xor(s2, o); }
            const float mean = s1 * (1.f / 64.f); const float var = fmaxf(s2 * (1.f / 64.f) - mean * mean, 0.f);
            const float y = (v - mean) * rsqrtf(var + EPS) * ng[h2];
            MIX[(row0 + t) * DM + MIX_M + h2 * 64 + lane] = f2bf(y * sigmoidf_(ov[k])); }
    }
}

DI void mlstm_out_wave_unit(const Params& p, unsigned char* ldsw, int l, int b, int c, int h, int lane) {
    asm volatile("" : "+v"(lane));
    const int fr = lane & 15, fq = lane >> 4;
    unsigned char* ws = p.ws; asm volatile("" : "+s"(ws));
    const bf16_t* P = (const bf16_t*)(ws + WS_P); bf16_t* MIX = (bf16_t*)(ws + WS_ACT); const float* GATES = (const float*)(ws + WS_GATES);
    const float* M0 = (const float*)(ws + WS_M0); const bf16_t* C0 = (const bf16_t*)(ws + WS_C0); const float* N0 = (const float*)(ws + WS_N0);
    bf16_t* Vt = (bf16_t*)ldsw;
    bf16_t* Sp = (bf16_t*)(ldsw + 11520);
    float* scal = (float*)(ldsw + 13824);
    bf16_t* Ot = (bf16_t*)(ldsw + 15360);
    const size_t row0 = (size_t)b * TT + c * 64;
    LDSFENCE();
#pragma unroll
    for (int cg = 0; cg < 8; ++cg) { const u32x4 v = *(const u32x4*)(P + (row0 + lane) * DINP + C_MV + h * 64 + 8 * cg); const unsigned vv[4] = {v.x, v.y, v.z, v.w};
#pragma unroll
        for (int e = 0; e < 4; ++e) { Vt[(8 * cg + 2 * e) * 72 + lane] = (bf16_t)(vv[e] & 0xffffu); Vt[(8 * cg + 2 * e + 1) * 72 + lane] = (bf16_t)(vv[e] >> 16); } }
#pragma unroll
    for (int i = 0; i < 16; ++i) Vt[(64 + i) * 72 + lane] = (bf16_t)0x3F80;
    const bf16_t* Qg = P + row0 * DINP + C_MQ + h * 64 + 8 * fq; const bf16_t* Kg = P + row0 * DINP + C_MK + h * 64 + 8 * fq;
    bf16x8 kf[4][2];
#pragma unroll
    for (int kk = 0; kk < 2; ++kk)
#pragma unroll
        for (int ns = 0; ns < 4; ++ns) kf[ns][kk] = *(const bf16x8*)(Kg + (size_t)(16 * ns + fr) * DINP + 32 * kk);
    const float* gb = p.mgate_b + l * 16;
    float m0d[2]; const bf16_t* C0d[2]; bf16x8 nf[2][2];
#pragma unroll
    for (int d = 0; d < 2; ++d) {
        const int tau = d ? 63 - lane : lane;
        const float* G = GATES + (row0 + tau) * 16;
        const float li = G[(2 * d) * 4 + h] + gb[(2 * d) * 4 + h]; const float lf = logsigmoidf_(G[(2 * d + 1) * 4 + h] + gb[(2 * d + 1) * 4 + h]);
        const float bc = prefix_sum(lf, lane); const float cs = li - bc; const float mx = prefix_max(cs, lane);
        const int nd = d ? (c < 4 ? 3 - c : 71 - c) : c; const int sid = (b * 4 + h) * 2 + d;
        const float m0 = M0[sid * NCH + nd]; const float mu = fmaxf(mx, m0);
        m0d[d] = m0; C0d[d] = C0 + ((size_t)sid * NCH + nd) * 4096 + fr * 64 + 8 * fq;
        scal[d * 192 + tau] = cs; scal[d * 192 + 64 + tau] = mu; scal[d * 192 + 128 + tau] = bc;
        const float* N0p = N0 + ((size_t)sid * NCH + nd) * 64;
#pragma unroll
        for (int kk = 0; kk < 2; ++kk) { float f[8];
#pragma unroll
            for (int j = 0; j < 8; ++j) f[j] = N0p[32 * kk + 8 * fq + j];
            nf[d][kk] = __builtin_bit_cast(bf16x8, pack8(f)); }
    }
    float ng[4];
#pragma unroll
    for (int et = 0; et < 4; ++et) ng[et] = p.mnorm[l * 256 + h * 64 + 16 * et + fr];
    LDSFENCE();
#pragma unroll 1
    for (int mt = 0; mt < 4; ++mt) {
        bf16x8 qa[2];
#pragma unroll
        for (int kk = 0; kk < 2; ++kk) qa[kk] = *(const bf16x8*)(Qg + (size_t)(16 * mt + fr) * DINP + 32 * kk);
#pragma unroll
        for (int i = 0; i < 2; ++i) { const int idx = lane + 64 * i, tl = idx >> 3, cg = idx & 7; *(u32x4*)(Ot + tl * 72 + 8 * cg) = __builtin_nontemporal_load((const u32x4*)(P + (row0 + 16 * mt + tl) * DINP + C_MO + h * 64 + 8 * cg)); }
        f32x4 hacc[4];
#pragma unroll
        for (int et = 0; et < 4; ++et) hacc[et] = (f32x4){0.f, 0.f, 0.f, 0.f};
#pragma unroll
        for (int d = 0; d < 2; ++d) {
            const float* sc = scal + d * 192;
#pragma unroll
            for (int ns = 0; ns < 4; ++ns) { f32x4 s = {0.f, 0.f, 0.f, 0.f};
#pragma unroll
                for (int kk = 0; kk < 2; ++kk) s = MFMA16(qa[kk], kf[ns][kk], s);
                const int sx = 16 * ns + fr; const float csx = sc[sx];
#pragma unroll
                for (int j = 0; j < 4; ++j) { const int t = 16 * mt + 4 * fq + j; const bool ok = d ? (sx >= t) : (sx <= t); const float val = ok ? s[j] * 0.125f * __expf(csx - sc[64 + t]) : 0.f; Sp[(4 * fq + j) * 72 + sx] = f2bf(val); } }
            LDSFENCE();
            f32x4 aS[5], aI[5];
#pragma unroll
            for (int et = 0; et < 5; ++et) { aS[et] = (f32x4){0.f, 0.f, 0.f, 0.f}; aI[et] = (f32x4){0.f, 0.f, 0.f, 0.f}; }
#pragma unroll
            for (int kk = 0; kk < 2; ++kk) { const bf16x8 sa = *(const bf16x8*)(Sp + fr * 72 + 32 * kk + 8 * fq);
#pragma unroll
                for (int et = 0; et < 5; ++et) { const bf16x8 vf = *(const bf16x8*)(Vt + (16 * et + fr) * 72 + 32 * kk + 8 * fq); aS[et] = MFMA16(sa, vf, aS[et]); }
#pragma unroll
                for (int et = 0; et < 4; ++et) { const bf16x8 cf = *(const bf16x8*)(C0d[d] + et * 1024 + 32 * kk); aI[et] = MFMA16(qa[kk], cf, aI[et]); }
                aI[4] = MFMA16(qa[kk], nf[d][kk], aI[4]); }
#pragma unroll
            for (int j = 0; j < 4; ++j) { const int t = 16 * mt + 4 * fq + j; const float mut = sc[64 + t]; const float fi = __expf(m0d[d] - mut); const float den = fi * aI[4][j] + aS[4][j];
                const float lim = __expf(-sc[128 + t] - mut); const float inv = frcp(fmaxf(fabsf(den), lim));
#pragma unroll
                for (int et = 0; et < 4; ++et) hacc[et][j] += (fi * aI[et][j] + aS[et][j]) * inv; }
            LDSFENCE();
        }
#pragma unroll
        for (int j = 0; j < 4; ++j) { const int tl = 4 * fq + j;
            float s1 = 0.f, s2 = 0.f;
#pragma unroll
            for (int et = 0; et < 4; ++et) { const float v = hacc[et][j]; s1 += v; s2 += v * v; }
#pragma unroll
            for (int o = 1; o < 16; o <<= 1) { s1 += __shfl_xor(s1, o); s2 += __shfl_xor(s2, o); }
            const float mean = s1 * (1.f / 64.f); const float var = fmaxf(s2 * (1.f / 64.f) - mean * mean, 0.f); const float rs = rsqrtf(var + EPS);
#pragma unroll
            for (int et = 0; et < 4; ++et) { const float y = (hacc[et][j] - mean) * rs * ng[et]; const float o = bf2f(Ot[tl * 72 + 16 * et + fr]); Ot[tl * 72 + 16 * et + fr] = f2bf(y * sigmoidf_(o)); } }
        LDSFENCE();
#pragma unroll
        for (int i = 0; i < 2; ++i) { const int idx = lane + 64 * i, tl = idx >> 3, cg = idx & 7; *(u32x4*)(MIX + (row0 + 16 * mt + tl) * DM + MIX_M + h * 64 + 8 * cg) = *(const u32x4*)(Ot + tl * 72 + 8 * cg); }
        LDSFENCE();
    }
}

template <bool FINAL> DI void lru_wave_unit(const Params& p, unsigned char* ldsw, int l, int b, int c, int blk, int lane, int dmask = 3) {
    asm volatile("" : "+v"(lane));
    const int fr = lane & 15, fq = lane >> 4;
    unsigned char* ws = p.ws; asm volatile("" : "+s"(ws));
    const bf16_t* P = (const bf16_t*)(ws + WS_P); bf16_t* MIX = (bf16_t*)(ws + WS_ACT); const bf16_t* LW = (const bf16_t*)(ws + WS_LW);
    float2* LAGG = (float2*)(ws + WS_LAGG); const float* CARRY = (const float*)(ws + WS_CARRY);
    bf16_t* seqb = (bf16_t*)ldsw;
    float2* priv = (float2*)(ldsw + 4608);
    const size_t rowb = (size_t)b * TT; const int t0 = c * 32; const int seg_lo = t0 < NC ? 0 : NC, seg_hi = t0 < NC ? NC : TT;
    const int chs = blk * 64 + lane;
#pragma unroll
    for (int it = 0; it < 4; ++it) { const int idx = lane + 64 * it, tl = idx >> 3, cg = idx & 7, t = t0 + tl, ch0 = blk * 64 + 8 * cg;
        float s[8]; { const float4 b0 = *(const float4*)(p.conv_b + l * 256 + ch0), b1 = *(const float4*)(p.conv_b + l * 256 + ch0 + 4); s[0] = b0.x; s[1] = b0.y; s[2] = b0.z; s[3] = b0.w; s[4] = b1.x; s[5] = b1.y; s[6] = b1.z; s[7] = b1.w; }
#pragma unroll
        for (int j = 0; j < 4; ++j) { const int tt = t + j - 2; if (tt >= seg_lo && tt < seg_hi) { const u32x4 xv = __builtin_nontemporal_load((const u32x4*)(P + (rowb + tt) * DINP + C_RX + ch0)); float f[8]; unpack8(xv, f);
                const float* cw = p.conv_w + (size_t)(l * 4 + j) * 256 + ch0; const float4 w0 = *(const float4*)cw, w1 = *(const float4*)(cw + 4);
                s[0] += w0.x * f[0]; s[1] += w0.y * f[1]; s[2] += w0.z * f[2]; s[3] += w0.w * f[3]; s[4] += w1.x * f[4]; s[5] += w1.y * f[5]; s[6] += w1.z * f[6]; s[7] += w1.w * f[7]; } }
        *(u32x4*)(seqb + tl * 72 + 8 * cg) = pack8(s); }
    LDSFENCE();
    float hreg[32];
#pragma unroll
    for (int d = 0; d < 2; ++d) {
        __builtin_amdgcn_sched_barrier(0);
        if (!FINAL && !((dmask >> d) & 1)) continue;
        const bf16_t* LWp = LW + ((size_t)((l * 2 + d) * 2) * 4 + blk) * 4096 + fr * 64 + 8 * fq;
        float gbr[4], gbi[4], sp8[4];
#pragma unroll
        for (int nt = 0; nt < 4; ++nt) { const int ch = blk * 64 + 16 * nt + fr; gbr[nt] = p.lru_b[(size_t)((l * 2 + d) * 2 + 0) * 256 + ch]; gbi[nt] = p.lru_b[(size_t)((l * 2 + d) * 2 + 1) * 256 + ch];
            sp8[nt] = 8.f * softplusf_(-p.lru_lam[(size_t)(l * 2 + d) * 256 + ch]); }
        const bool small_decay = __builtin_amdgcn_ballot_w64(fmaxf(fmaxf(sp8[0], sp8[1]), fmaxf(sp8[2], sp8[3])) >= 0.12f) == 0ull;
        const int nd = d ? (c < 8 ? 7 - c : 143 - c) : c;
        const size_t aidx = (((size_t)b * NCH32 + nd) * 2 + d) * 256 + chs;
        float hst = FINAL ? CARRY[aidx] : 0.f, ap = 1.f;
#pragma unroll
        for (int mi = 0; mi < 2; ++mi) { const int mt = d ? 1 - mi : mi;
            f32x4 ar[4], ai[4];
#pragma unroll
            for (int nt = 0; nt < 4; ++nt) { ar[nt] = (f32x4){0.f, 0.f, 0.f, 0.f}; ai[nt] = (f32x4){0.f, 0.f, 0.f, 0.f}; }
            { const bf16_t* LWq = LWp; asm volatile("" : "+v"(LWq));
#pragma unroll
            for (int kk = 0; kk < 2; ++kk) { const bf16x8 a = *(const bf16x8*)(seqb + (16 * mt + fr) * 72 + 32 * kk + 8 * fq);
#pragma unroll
                for (int nt = 0; nt < 4; ++nt) { const bf16x8 w0 = *(const bf16x8*)(LWq + nt * 1024 + 32 * kk), w1 = *(const bf16x8*)(LWq + 16384 + nt * 1024 + 32 * kk); ar[nt] = MFMA16(a, w0, ar[nt]); ai[nt] = MFMA16(a, w1, ai[nt]); } } }
#pragma unroll
            for (int nt = 0; nt < 4; ++nt)
#pragma unroll
                for (int jp = 0; jp < 2; ++jp) { const int tl = 4 * fq + 2 * jp;
                    const f32x2_hw xr = (f32x2_hw){ar[nt][2 * jp], ar[nt][2 * jp + 1]} + gbr[nt], xi = (f32x2_hw){ai[nt][2 * jp], ai[nt][2 * jp + 1]} + gbi[nt];
                    const f32x2_hw xr2 = xr * -1.4426950408889634f, xi2 = xi * -1.4426950408889634f;
                    f32x2_hw ex, ey; ex.x = __builtin_amdgcn_exp2f(xr2.x); ex.y = __builtin_amdgcn_exp2f(xr2.y); ey.x = __builtin_amdgcn_exp2f(xi2.x); ey.y = __builtin_amdgcn_exp2f(xi2.y);
                    ex = ex + 1.f; ey = ey + 1.f;
                    const f32x2_hw den = ex * ey; f32x2_hw R; R.x = frcp(den.x); R.y = frcp(den.y);
                    const f32x2_hw r = ey * R, ig = ex * R;
                    const f32x2_hw la = r * -sp8[nt];
                    f32x2_hw a, nem;
                    if (small_decay) { a = la * (la * (la * (la * (la * 0.008333334f + 0.041666668f) + 0.16666667f) + 0.5f) + 1.f) + 1.f; const f32x2_hw x2 = la * 2.f; nem = (x2 * (x2 * (x2 * (x2 * (x2 * 0.008333334f + 0.041666668f) + 0.16666667f) + 0.5f) + 1.f)) * -1.f; }
                    else { a.x = __expf(la.x); a.y = __expf(la.y); nem.x = neg_expm1(2.f * la.x); nem.y = neg_expm1(2.f * la.y); }
                    f32x2_hw sq; sq.x = __builtin_amdgcn_sqrtf(nem.x); sq.y = __builtin_amdgcn_sqrtf(nem.y);
                    const f32x2_hw sv = {bf2f(seqb[(16 * mt + tl) * 72 + 16 * nt + fr]), bf2f(seqb[(16 * mt + tl + 1) * 72 + 16 * nt + fr])};
                    const f32x2_hw u = sq * ig * sv;
                    priv[tl * 64 + 16 * nt + fr] = make_float2(a.x, u.x); priv[(tl + 1) * 64 + 16 * nt + fr] = make_float2(a.y, u.y); }
            LDSFENCE();
#pragma unroll
            for (int ti = 0; ti < 16; ++ti) { const int tl = d ? 15 - ti : ti; const float2 au = priv[tl * 64 + lane]; hst = au.x * hst + au.y; ap *= au.x;
                if (FINAL) { if (d == 0) hreg[16 * mt + tl] = hst; else hreg[16 * mt + tl] += hst; } }
            LDSFENCE();
        }
        if (!FINAL) LAGG[aidx] = make_float2(ap, hst);
    }
    if (FINAL) {
#pragma unroll
        for (int t8 = 0; t8 < 32; t8 += 8) { float yv[8];
#pragma unroll
            for (int t = 0; t < 8; ++t) yv[t] = bf2f(__builtin_nontemporal_load(&P[(rowb + t0 + t8 + t) * DINP + C_RY + chs]));
#pragma unroll
            for (int t = 0; t < 8; ++t) MIX[(rowb + t0 + t8 + t) * DM + MIX_R + chs] = f2bf(hreg[t8 + t] * gelu_tanh(yv[t])); }
    }
}

DI void lru_scan_unit(const Params& p, int b) {
    int tid_l = threadIdx.x; asm volatile("" : "+v"(tid_l)); const int tid = tid_l, d = tid >> 8, ch = tid & 255;
    unsigned char* ws = p.ws; asm volatile("" : "+s"(ws));
    const float2* LAGG = (const float2*)(ws + WS_LAGG); float* CARRY = (float*)(ws + WS_CARRY);
    float carry = 0.f;
#pragma unroll 1
    for (int n0 = 0; n0 < NCH32; n0 += 17) { float2 v[17];
#pragma unroll
        for (int k = 0; k < 17; ++k) v[k] = LAGG[(((size_t)b * NCH32 + n0 + k) * 2 + d) * 256 + ch];
#pragma unroll
        for (int k = 0; k < 17; ++k) { CARRY[(((size_t)b * NCH32 + n0 + k) * 2 + d) * 256 + ch] = carry; carry = v[k].x * carry + v[k].y; } }
}

#define LAS __attribute__((address_space(3)))
#define XB_TMO      128
#define XB_XCNT(j)  (256  + 64 * (j))
#define XB_XSUB(j)  (1280 + 64 * (j))
#define XB_XGEN(j)  (2304 + 64 * (j))
#define XB_TOP      3328
#define XB_TOPGEN   3392
#define XCD_BAR_WORDS 3456
#define XB_SPIN_CAP (1u << 18)

__device__ __forceinline__ unsigned xb_ld(unsigned* p)              { return __hip_atomic_load(p, __ATOMIC_RELAXED, __HIP_MEMORY_SCOPE_AGENT); }
__device__ __forceinline__ unsigned xb_add(unsigned* p, unsigned v) { return __hip_atomic_fetch_add(p, v, __ATOMIC_RELAXED, __HIP_MEMORY_SCOPE_AGENT); }
__device__ __forceinline__ unsigned xb_xcc_id() { return (unsigned)__builtin_amdgcn_s_getreg((3 << 11) | 20) & 0xFu; }
#define XB_SPIN(cond, bar) do { unsigned _sp = 0; while (cond) { __builtin_amdgcn_s_sleep(1); \
    if ((++_sp & 255u) == 0u) { if (xb_ld(&(bar)[XB_TMO])) break; if (_sp > XB_SPIN_CAP) { atomicAdd(&(bar)[XB_TMO], 1u); break; } } } } while (0)

struct XcdBarrier {
    unsigned* bar; unsigned x;
    volatile LAS unsigned* st;
};

__device__ __forceinline__ XcdBarrier xcd_barrier_post(unsigned* bar, volatile LAS unsigned* st) {
    XcdBarrier b; b.bar = bar; b.x = xb_xcc_id(); b.st = st;
    if (threadIdx.x == 0) (void)xb_add(&bar[XB_XCNT(b.x)], 1u);
    return b;
}
__device__ __forceinline__ void xcd_barrier_complete(unsigned* bar, unsigned x, unsigned& nloc, unsigned& nx) {
    const unsigned G = gridDim.x * gridDim.y * gridDim.z;
    unsigned sum, cnt, mine, sp = 0u;
    for (;;) {
        sum = 0u; cnt = 0u; mine = 0u;
#pragma unroll
        for (unsigned j = 0; j < 16; ++j) { const unsigned c = xb_ld(&bar[XB_XCNT(j)]); sum += c; cnt += (c > 0u) ? 1u : 0u; mine = (j == x) ? c : mine; }
        if (sum == G) break;
        __builtin_amdgcn_s_sleep(1);
        if ((++sp & 255u) == 0u) { if (xb_ld(&bar[XB_TMO])) break; if (sp > XB_SPIN_CAP) { atomicAdd(&bar[XB_TMO], 1u); break; } }
    }
    nloc = mine > 0u ? mine : 1u; nx = cnt > 0u ? cnt : 1u;
}

__device__ __forceinline__ void xcd_barrier(const XcdBarrier& b) {
    asm volatile("s_waitcnt vmcnt(0)" ::: "memory");
    __syncthreads();
    if (threadIdx.x == 0) {
        unsigned* bar = b.bar;
        __builtin_amdgcn_s_waitcnt(0);
        unsigned nloc = b.st[0], nx = b.st[1];
        if (nloc == 0u) { xcd_barrier_complete(bar, b.x, nloc, nx); b.st[0] = nloc; b.st[1] = nx; }
        const unsigned old = xb_add(&bar[XB_XSUB(b.x)], 1u);
        const unsigned gen = old / nloc;
        if (old + 1u == (gen + 1u) * nloc) {
            __builtin_amdgcn_fence(__ATOMIC_RELEASE, "agent");
            asm volatile("s_waitcnt vmcnt(0)" ::: "memory");
            const unsigned og = xb_add(&bar[XB_TOP], 1u);
            const unsigned tg = og / nx;
            if (og + 1u == (tg + 1u) * nx) xb_add(&bar[XB_TOPGEN], 1u);
            else XB_SPIN(xb_ld(&bar[XB_TOPGEN]) == tg, bar);
            __builtin_amdgcn_fence(__ATOMIC_ACQUIRE, "agent");
            xb_add(&bar[XB_XGEN(b.x)], 1u);
            asm volatile("s_waitcnt vmcnt(0)" ::: "memory");
        } else {
            XB_SPIN(xb_ld(&bar[XB_XGEN(b.x)]) == gen, bar);
            __builtin_amdgcn_fence(__ATOMIC_ACQUIRE, "agent");
            asm volatile("s_waitcnt vmcnt(0)" ::: "memory");
        }
    }
    __syncthreads();
}

typedef const volatile __attribute__((address_space(4))) Params* KParamsPtr;
DI Params kload() { KParamsPtr kp = (KParamsPtr)__builtin_amdgcn_kernarg_segment_ptr(); Params q;
    q.x = (const float*)kp->x;
    q.c = (const float*)kp->c;
    q.ctx = (const float*)kp->ctx;
    q.c_ctx = (const float*)kp->c_ctx;
    q.w_ada = (const float*)kp->w_ada;
    q.b_ada = (const float*)kp->b_ada;
    q.norm_gain = (const float*)kp->norm_gain;
    q.w_in = (const float*)kp->w_in;
    q.w_out = (const float*)kp->w_out;
    q.attn_sink = (const float*)kp->attn_sink;
    q.mgate_b = (const float*)kp->mgate_b;
    q.mnorm = (const float*)kp->mnorm;
    q.conv_w = (const float*)kp->conv_w;
    q.conv_b = (const float*)kp->conv_b;
    q.lru_w = (const float*)kp->lru_w;
    q.lru_b = (const float*)kp->lru_b;
    q.lru_lam = (const float*)kp->lru_lam;
    q.w_f1 = (const float*)kp->w_f1;
    q.w_f2 = (const float*)kp->w_f2;
    q.out = (float*)kp->out; q.ws = (unsigned char*)kp->ws; q.ph_lo = 0; q.ph_hi = 0; return q; }

__global__ void __launch_bounds__(NTHR, 2) fwd_kernel(Params p) {
    extern __shared__ __attribute__((aligned(16))) unsigned char lds[];
    cg::grid_group grid = cg::this_grid();
    const int lo = p.ph_lo, hi = p.ph_hi;
    volatile LAS unsigned* bst = (volatile LAS unsigned*)((LAS unsigned char*)lds + (LDS_BYTES - 64));
    if (threadIdx.x < 16) bst[threadIdx.x] = 0u;
    __syncthreads();
    (void)xcd_barrier_post((unsigned*)(p.ws + WS_BAR), bst);
    if (lo > 1000) grid.sync();
#ifndef ENMASK
#define ENMASK 0xffff
#endif
#define EN(b) ((ENMASK >> (b)) & 1)
#ifndef DUPMASK
#define DUPMASK 0
#endif
#define REP(b) for (int rep_ = 0; rep_ < 1 + ((DUPMASK >> (b)) & 1); ++rep_)
#define IN(k) (lo <= (k) && (k) < hi)
#ifndef DUPMASK
#define DUPMASK 0
#endif
#define SEAM(k) do { if (IN(k) && IN((k) + 1)) { XcdBarrier xb_; xb_.bar = (unsigned*)(((KParamsPtr)__builtin_amdgcn_kernarg_segment_ptr())->ws + WS_BAR); xb_.x = xb_xcc_id(); xb_.st = (volatile LAS unsigned*)((LAS unsigned char*)lds + (LDS_BYTES - 64)); xcd_barrier(xb_); if ((DUPMASK >> 15) & 1) xcd_barrier(xb_); } } while (0)
#define LAUNDER() const Params q = kload(); int l = l0; unsigned char* ws = q.ws; int G = gridDim.x, bid = blockIdx.x; asm volatile("" : "+s"(l), "+s"(ws), "+s"(G), "+s"(bid))
    if (EN(0) && IN(0)) REP(0) { const Params q = kload(); phase_setup(q, lds); }
    SEAM(0);
#pragma unroll 1
    for (int l0 = 0; l0 < DEPTH; ++l0) {
        const int pb = 1 + 9 * l0;
        if (EN(1) && IN(pb + 0)) REP(1) { LAUNDER(); phase_rows(q, lds, l, 0, rep_ ? 0.f : 1.f); }
        SEAM(pb + 0);
        if (EN(2) && IN(pb + 1)) REP(2) { LAUNDER(); pg8::Gemm g{(bf16_t*)(ws + WS_ACT), (const bf16_t*)(ws + WS_WIN) + (size_t)l * DINP * 1024, MR, DINP, 1024}; pg8::StaticOrder S; S.init(MR, DINP, G, bid); pg8::EpiStore E{(bf16_t*)(ws + WS_P), DINP};
            pg8::gemm_phase<pg8::EpiStore, pg8::StaticOrder, true, true>((PG8_LAS unsigned char*)lds, g, S, E); }
        SEAM(pb + 1);
        if (IN(pb + 2)) REP(3) { LAUNDER();
            const bool need_ctx = l < DEPTH - 1;
            const int nA = 1024 + (need_ctx ? 64 : 0), nM = NB * NCH;
#pragma unroll 1
            for (int u = bid; u < nA + nM; u += G) {
                if (u < 1024) { if (EN(3)) REP(16) attn_unit(q, lds, l, u >> 7, (u >> 1) & 63, u & 1, false); }
                else if (u < nA) { const int v = u - 1024; if (EN(12)) attn_unit(q, lds, l, v >> 3, (v >> 1) & 3, v & 1, true); }
                else { const int v = u - nA; if (EN(10)) REP(10) mlstm_local_unit(q, lds, l, v / NCH, v % NCH); }
            }
            __syncthreads();
            { int tidw = threadIdx.x; asm volatile("" : "+v"(tidw)); const int wave = __builtin_amdgcn_readfirstlane(tidw >> 6), lane = tidw & 63;
              { const int W = G * 8, wr = ((bid + 96) % G) * 8 + wave, nU = NB * NCH32 * 4, nFull = (nU / W) * W;
#pragma unroll 1
                for (int wu = wr; wu < nFull; wu += W) { const int v = wu >> 2; if (EN(9)) REP(9) lru_wave_unit<false>(q, lds + wave * 12800, l, v / NCH32, v % NCH32, wu & 3, lane); }
                if (wr < 2 * (nU - nFull)) { const int wu = nFull + (wr >> 1), v = wu >> 2; if (EN(9)) REP(9) lru_wave_unit<false>(q, lds + wave * 12800, l, v / NCH32, v % NCH32, wu & 3, lane, 1 << (wr & 1)); } } }
        }
        SEAM(pb + 2);
        if (EN(4) && IN(pb + 3)) REP(4) { LAUNDER();
#pragma unroll 1
            for (int u = bid; u < 512 + NB; u += G) { if (u >= NB) mlstm_scan_unit(q, lds, u - NB); else lru_scan_unit(q, u); } }
        SEAM(pb + 3);
        if (IN(pb + 4)) REP(5) { LAUNDER();
            { int tidw = threadIdx.x; asm volatile("" : "+v"(tidw)); const int wave = __builtin_amdgcn_readfirstlane(tidw >> 6), lane = tidw & 63;
              const int nMW = NB * NCH * 4, nLW = NB * NCH32 * 4;
              const int W = G * 8, w = bid * 8 + wave;
              if (W == 2048) {
#pragma unroll 1
                  for (int u = (w + 128) & 2047; u < nMW; u += 2048) { const int v = u >> 2; if (EN(5)) REP(13) mlstm_out_wave_unit(q, lds + wave * 17920, l, v / NCH, v % NCH, u & 3, lane); }
#pragma unroll 1
                  for (int k = 0; k < 3; ++k) {
                      int u = -1;
                      if (w < 1920) { if (k < 2) u = 2 * w + k; else if (w < 384) u = 3968 + w; } else if (k == 0) u = 3840 + (w - 1920);
                      if (u >= 0 && u < nLW) { const int v = u >> 2; if (EN(11)) REP(14) lru_wave_unit<true>(q, lds + wave * 17920, l, v / NCH32, v % NCH32, u & 3, lane); } }
              } else {
#pragma unroll 1
              for (int wu = w; wu < nMW + nLW; wu += W) {
                  if (wu < nMW) { const int v = wu >> 2; if (EN(5)) REP(13) mlstm_out_wave_unit(q, lds + wave * 17920, l, v / NCH, v % NCH, wu & 3, lane); }
                  else { const int w2 = wu - nMW, v = w2 >> 2; if (EN(11)) REP(14) lru_wave_unit<true>(q, lds + wave * 17920, l, v / NCH32, v % NCH32, w2 & 3, lane); } } } }
        }
        SEAM(pb + 4);
        if (EN(6) && IN(pb + 5)) REP(6) { LAUNDER(); __syncthreads(); pg8::Gemm g{(bf16_t*)(ws + WS_ACT), (const bf16_t*)(ws + WS_WOUT) + (size_t)l * 1024 * 1024, MR, 1024, 1024}; pg8::StaticOrder S; S.init(MR, 1024, G, bid, l == DEPTH - 1); pg8::EpiStore E{(bf16_t*)(ws + WS_Y), 1024};
            pg8::gemm_phase<pg8::EpiStore, pg8::StaticOrder, true, true>((PG8_LAS unsigned char*)lds, g, S, E); }
        SEAM(pb + 5);
        if (EN(1) && IN(pb + 6)) for (int rep_ = 0; rep_ < 1 + (((DUPMASK >> 1) & 1) && l0 > 0); ++rep_) { LAUNDER(); phase_rows(q, lds, l, 1, rep_ ? 0.f : 1.f); }
        SEAM(pb + 6);
        if (EN(7) && IN(pb + 7)) REP(7) { LAUNDER(); pg8::Gemm g{(bf16_t*)(ws + WS_ACT), (const bf16_t*)(ws + WS_WF1) + (size_t)l * 2 * DFF * 1024, MR, 2 * DFF, 1024}; pg8::StaticOrder S; S.init(MR, 2 * DFF, G, bid, l == DEPTH - 1); pg8::EpiSwiglu E{(bf16_t*)(ws + WS_P), DFF};
            pg8::gemm_phase<pg8::EpiSwiglu, pg8::StaticOrder, true, true>((PG8_LAS unsigned char*)lds, g, S, E); }
        SEAM(pb + 7);
        if (EN(8) && IN(pb + 8)) REP(8) { LAUNDER(); pg8::Gemm g{(bf16_t*)(ws + WS_P), (const bf16_t*)(ws + WS_WF2) + (size_t)l * 1024 * DFF, MR, 1024, DFF}; pg8::StaticOrder S; S.init(MR, 1024, G, bid, l == DEPTH - 1); pg8::EpiStore E{(bf16_t*)(ws + WS_Y), 1024};
            pg8::gemm_phase<pg8::EpiStore, pg8::StaticOrder, true, true>((PG8_LAS unsigned char*)lds, g, S, E);
            if (rep_ == 0 && l < DEPTH - 1) { __syncthreads(); convert_layer(q, lds, l + 1, 32, G - 32); } }
        SEAM(pb + 8);
    }
    if (EN(1) && IN(37)) { const Params q = kload(); int l = 3; asm volatile("" : "+s"(l)); phase_rows(q, lds, l, 2); }
#undef IN
#undef SEAM
}

#ifndef MK_PER_PHASE
#define MK_PER_PHASE 0
#endif
constexpr int N_PHASES = 38;

extern "C" void kernel_launch(void* const* d_in, const int* in_sizes, int n_in, void* d_out, int out_size, void* d_ws, size_t ws_size, hipStream_t stream) {
    static int grid = 0;
    if (grid == 0) {
        if (n_in != 19 || ws_size < WS_END) { fprintf(stderr, "kernel_launch: unexpected n_in %d or ws_size %zu (need %zu)\n", n_in, ws_size, (size_t)WS_END); grid = -1; return; }
        if (hipFuncSetAttribute((const void*)fwd_kernel, hipFuncAttributeMaxDynamicSharedMemorySize, LDS_BYTES) != hipSuccess) { fprintf(stderr, "kernel_launch: hipFuncSetAttribute failed\n"); grid = -1; return; }
        int dev = 0, cus = 0, per_cu = 0;
        hipGetDevice(&dev); hipDeviceGetAttribute(&cus, hipDeviceAttributeMultiprocessorCount, dev);
        hipOccupancyMaxActiveBlocksPerMultiprocessor(&per_cu, (const void*)fwd_kernel, NTHR, LDS_BYTES);
        if (per_cu < 1) { fprintf(stderr, "kernel_launch: occupancy query says %d blocks per CU\n", per_cu); per_cu = 1; }
        (void)hipGetLastError();
        grid = cus;
    }
    if (grid < 0) return;
    Params p{};
    const float** pp = (const float**)&p;
    for (int i = 0; i < 19; ++i) pp[i] = (const float*)d_in[i];
    p.out = (float*)d_out; p.ws = (unsigned char*)d_ws;
#if MK_PER_PHASE
    for (int k = 0; k < N_PHASES; ++k) { p.ph_lo = k; p.ph_hi = k + 1; hipLaunchKernelGGL(fwd_kernel, dim3(grid), dim3(NTHR), LDS_BYTES, stream, p); }
#else
    p.ph_lo = 0; p.ph_hi = N_PHASES;
    if (hipMemsetAsync((char*)d_ws + WS_BAR, 0, 16384, stream) != hipSuccess) { fprintf(stderr, "kernel_launch: memset failed\n"); return; }
    void* args[] = {&p};
    hipError_t e = hipLaunchCooperativeKernel((const void*)fwd_kernel, dim3(grid), dim3(NTHR), args, LDS_BYTES, stream);
    if (e != hipSuccess) fprintf(stderr, "cooperative launch failed: %s (grid %d)\n", hipGetErrorString(e), grid);
#endif
}
```

```cpp
#include <hip/hip_runtime.h>
#include <hip/hip_cooperative_groups.h>
#include <cstdio>
#include <cstdint>
namespace cg = cooperative_groups;
namespace pg8 {
#define PG8_LAS __attribute__((address_space(3)))
typedef unsigned short bf16_t;
typedef short bf16x8 __attribute__((ext_vector_type(8)));
typedef float f32x4 __attribute__((ext_vector_type(4)));
typedef unsigned u32x4 __attribute__((ext_vector_type(4)));
constexpr int BM = 256, BK = 64, HALF = 128, HTB = HALF * BK * 2  , STAGE_BYTES = 8 * HTB, NXCD = 8, WGM = 8;

__host__ __device__ __forceinline__ int lds_byte(int r, int c) { const int st = (r >> 4) * 2 + (c >> 5), rr = r & 15, cc = c & 31, ob = rr * 64 + cc * 2; return st * 1024 + (ob ^ (((ob >> 9) & 1) << 5)); }
__host__ __device__ __forceinline__ void stage_rc(int b, int& R, int& C) { const int st = b / 1024, sb = b % 1024, swz = sb ^ (((sb >> 9) & 1) << 5); R = (st >> 1) * 16 + swz / 64; C = (st & 1) * 32 + (swz % 64) / 2; }
__host__ __device__ __forceinline__ int perm32(int rho) { const int n = rho >> 4, i = rho & 15; return 8 * (i >> 2) + 4 * n + (i & 3); }

struct Unit { int pm, pn; };
struct Gemm { const bf16_t* A; const bf16_t* Bt; int M, N, K; };

struct StaticOrder {
    int nM, nN, nwg, G, c, skipc;
    __host__ __device__ void init(int M, int N, int G_, int c_, int skipc_ = 0) { nM = skipc_ ? (M / BM) / 17 * 16 : M / BM; nN = N / BM; nwg = nM * nN; G = G_; c = c_; skipc = skipc_; }
    __host__ __device__ bool next(int i, Unit& u) const {
        const long L = (long)i * G + c; if (L >= nwg) return false;
        int wgid = (int)L; { const int q = nwg / NXCD, r = nwg % NXCD, xcd = wgid % NXCD, off = wgid / NXCD; wgid = (xcd < r ? xcd * (q + 1) : r * (q + 1) + (xcd - r) * q) + off; }
        const int nig = WGM * nN, gid = wgid / nig, fm = gid * WGM, gsz = (nM - fm) < WGM ? (nM - fm) : WGM;
        u.pm = fm + ((wgid % nig) % gsz); u.pn = (wgid % nig) / gsz; if (skipc) u.pm = (u.pm >> 4) * 17 + 1 + (u.pm & 15); return true;
    }
    __device__ __forceinline__ void a_ready(const Unit&) const {}
    __device__ __forceinline__ void done(const Unit&) const {}
};

typedef __bf16 bf16x2_cv __attribute__((ext_vector_type(2)));
typedef float f32x2_cv __attribute__((ext_vector_type(2)));
__device__ __forceinline__ unsigned cvt_pk_bf16(float lo, float hi) { const f32x2_cv v = {lo, hi}; const bf16x2_cv b = __builtin_convertvector(v, bf16x2_cv); return __builtin_bit_cast(unsigned, b); }
typedef float f32x2 __attribute__((ext_vector_type(2)));
template <class Epi, class Sched, bool ALIGN_EPI = false, bool SP2 = false>
__device__ __forceinline__ void gemm_phase(PG8_LAS unsigned char* lds, const Gemm g, const Sched& S, const Epi& E) {
    int tid_l = threadIdx.x; asm volatile("" : "+v"(tid_l)); const int tid = tid_l, wid = __builtin_amdgcn_readfirstlane(tid >> 6), lane = tid & 63, wr = wid >> 2, wc = wid & 3, fr = lane & 15, fq = lane >> 4;
    const int K = g.K, nt = K / BK;
    unsigned voffA[2], voffB[2];
#pragma unroll
    for (int i = 0; i < 2; ++i) { int R, C; stage_rc(tid * 16 + i * 8192, R, C); const int Rb = Epi::PERM ? ((R & ~31) + perm32(R & 31)) : R;
        voffA[i] = (unsigned)(R * K + C) * 2u; voffB[i] = (unsigned)(Rb * K + C) * 2u; }
    const size_t kstep = (size_t)(BK * 2);
    const size_t hstep = (size_t)HALF * K * 2;
    const size_t tstep = 2 * hstep;
    const unsigned ldsw = (unsigned)wid * 1024u;
    const int aoff = lds_byte(wr * 64 + fr, fq * 8), boff = lds_byte(wc * 32 + fr, fq * 8);
#define PG8_SA(b, h) (((b) * 2 + (h)) * HTB)
#define PG8_SB(b, h) ((4 + (b) * 2 + (h)) * HTB)
#define PG8_STAGE(bufoff, gbase, voff) do { _Pragma("unroll") for (int _i = 0; _i < 2; ++_i) \
        __builtin_amdgcn_global_load_lds((const unsigned*)((const char*)(gbase) + (voff)[_i]), (PG8_LAS unsigned*)(lds + (bufoff) + ldsw + _i * 8192), 16, 0, 0); } while (0)
#define PG8_LDA(dst, b, h) do { _Pragma("unroll") for (int m = 0; m < 4; ++m) _Pragma("unroll") for (int k = 0; k < 2; ++k) dst[m][k] = *(const PG8_LAS bf16x8*)(lds + PG8_SA(b, h) + aoff + m * 2048 + k * 1024); } while (0)
#define PG8_LDB(dst, b, h) do { _Pragma("unroll") for (int n = 0; n < 2; ++n) _Pragma("unroll") for (int k = 0; k < 2; ++k) dst[n][k] = *(const PG8_LAS bf16x8*)(lds + PG8_SB(b, h) + boff + n * 2048 + k * 1024); } while (0)
#define PG8_MMA(ai, bj, At, Bt) do { __builtin_amdgcn_s_setprio(1); _Pragma("unroll") for (int m = 0; m < 4; ++m) _Pragma("unroll") for (int n = 0; n < 2; ++n) _Pragma("unroll") for (int k = 0; k < 2; ++k) \
        acc[ai][bj][m][n] = __builtin_amdgcn_mfma_f32_16x16x32_bf16(Bt[n][k], At[m][k], acc[ai][bj][m][n], 0, 0, 0); __builtin_amdgcn_s_setprio(0); } while (0)
#define PG8_WAIT_V(n) asm volatile("s_waitcnt vmcnt(" #n ")" ::: "memory")
#define PG8_WAIT_L(n) asm volatile("s_waitcnt lgkmcnt(" #n ")" ::: "memory")
#define PG8_BAR __builtin_amdgcn_s_barrier()
#define PG8_SCHED __builtin_amdgcn_sched_barrier(0)
    Unit cur, nxt; int ui = 0;
    if (!S.next(0, cur)) return;
    f32x4 acc[2][2][4][2];
#pragma unroll
    for (int a = 0; a < 2; ++a)
#pragma unroll
        for (int b = 0; b < 2; ++b)
#pragma unroll
            for (int m = 0; m < 4; ++m)
#pragma unroll
                for (int n = 0; n < 2; ++n) acc[a][b][m][n] = (f32x4){0.f, 0.f, 0.f, 0.f};
    bf16x8 At[4][2], B0[2][2], B1[2][2];
    const char* cA = (const char*)g.A + (size_t)cur.pm * tstep; const char* cB = (const char*)g.Bt + (size_t)cur.pn * tstep;
    S.a_ready(cur);
    if constexpr (SP2) {
        PG8_STAGE(PG8_SB(0, 0), cB, voffB); PG8_STAGE(PG8_SB(0, 1), cB + hstep, voffB); PG8_STAGE(PG8_SA(0, 0), cA, voffA); PG8_STAGE(PG8_SA(0, 1), cA + hstep, voffA);
        if (wr == 1) PG8_BAR;
        PG8_WAIT_V(2); PG8_BAR;
        PG8_STAGE(PG8_SB(1, 0), cB + kstep, voffB); PG8_STAGE(PG8_SA(1, 0), cA + kstep, voffA); PG8_STAGE(PG8_SB(1, 1), cB + hstep + kstep, voffB);
        PG8_WAIT_V(6); PG8_BAR;
    } else {
        PG8_STAGE(PG8_SB(0, 0), cB, voffB); PG8_STAGE(PG8_SA(0, 0), cA, voffA); PG8_STAGE(PG8_SB(0, 1), cB + hstep, voffB); PG8_STAGE(PG8_SA(0, 1), cA + hstep, voffA);
        if (wr == 1) PG8_BAR;
        PG8_WAIT_V(4); PG8_BAR;
        PG8_STAGE(PG8_SB(1, 0), cB + kstep, voffB); PG8_STAGE(PG8_SA(1, 0), cA + kstep, voffA); PG8_STAGE(PG8_SB(1, 1), cB + hstep + kstep, voffB);
        PG8_WAIT_V(6); PG8_BAR;
    }
    for (;;) {
        const bool has_next = S.next(ui + 1, nxt);
        const char* nA = has_next ? (const char*)g.A + (size_t)nxt.pm * tstep : cA; const char* nB = has_next ? (const char*)g.Bt + (size_t)nxt.pn * tstep : cB;
        for (int t = 0; t < nt; t += 2) {
            const bool last = (t == nt - 2);
            const char* a1 = cA + (size_t)(t + 1) * kstep;
            const char* a2 = last ? nA : cA + (size_t)(t + 2) * kstep; const char* b2 = last ? nB : cB + (size_t)(t + 2) * kstep;
            const char* a3 = a2 + kstep; const char* b3 = b2 + kstep;
            if (last && has_next) S.a_ready(nxt);
            if constexpr (SP2) {
            PG8_LDB(B0, 0, 0); PG8_LDB(B1, 0, 1); PG8_SCHED; PG8_LDA(At, 0, 0); PG8_STAGE(PG8_SA(1, 1), a1 + hstep, voffA);
            PG8_WAIT_V(8); PG8_WAIT_L(0); PG8_BAR; PG8_MMA(0, 0, At, B0); PG8_MMA(0, 1, At, B1); PG8_BAR; PG8_SCHED;
            PG8_LDA(At, 0, 1); PG8_STAGE(PG8_SB(0, 0), b2, voffB); PG8_STAGE(PG8_SB(0, 1), b2 + hstep, voffB); PG8_STAGE(PG8_SA(0, 0), a2, voffA);
            PG8_WAIT_V(8); PG8_WAIT_L(0); PG8_BAR; PG8_MMA(1, 0, At, B0); PG8_MMA(1, 1, At, B1); PG8_BAR; PG8_SCHED;
            PG8_LDB(B0, 1, 0); PG8_LDB(B1, 1, 1); PG8_SCHED; PG8_LDA(At, 1, 0); PG8_STAGE(PG8_SA(0, 1), a2 + hstep, voffA);
            PG8_WAIT_V(8); PG8_WAIT_L(0); PG8_BAR; PG8_MMA(0, 0, At, B0); PG8_MMA(0, 1, At, B1); PG8_BAR; PG8_SCHED;
            PG8_LDA(At, 1, 1); PG8_STAGE(PG8_SB(1, 0), b3, voffB); PG8_STAGE(PG8_SB(1, 1), b3 + hstep, voffB); PG8_STAGE(PG8_SA(1, 0), a3, voffA);
            PG8_WAIT_V(8); PG8_WAIT_L(0); PG8_BAR; PG8_MMA(1, 0, At, B0); PG8_MMA(1, 1, At, B1); PG8_BAR; PG8_SCHED;
            } else {
            PG8_LDB(B0, 0, 0); PG8_SCHED; PG8_LDA(At, 0, 0); PG8_STAGE(PG8_SA(1, 1), a1 + hstep, voffA);
            PG8_WAIT_L(8); PG8_BAR; PG8_WAIT_L(0); PG8_MMA(0, 0, At, B0); PG8_BAR; PG8_SCHED;
            PG8_LDB(B1, 0, 1); PG8_STAGE(PG8_SB(0, 0), b2, voffB);
            PG8_BAR; PG8_WAIT_L(0); PG8_MMA(0, 1, At, B1); PG8_BAR;
            PG8_LDA(At, 0, 1); PG8_STAGE(PG8_SA(0, 0), a2, voffA);
            PG8_BAR; PG8_WAIT_L(0); PG8_MMA(1, 0, At, B0); PG8_BAR; PG8_SCHED;
            PG8_STAGE(PG8_SB(0, 1), b2 + hstep, voffB);
            PG8_WAIT_V(6); PG8_BAR; PG8_MMA(1, 1, At, B1); PG8_BAR;
            PG8_LDB(B0, 1, 0); PG8_SCHED; PG8_LDA(At, 1, 0); PG8_STAGE(PG8_SA(0, 1), a2 + hstep, voffA);
            PG8_WAIT_L(8); PG8_BAR; PG8_WAIT_L(0); PG8_MMA(0, 0, At, B0); PG8_BAR; PG8_SCHED;
            PG8_LDB(B1, 1, 1); PG8_STAGE(PG8_SB(1, 0), b3, voffB);
            PG8_BAR; PG8_WAIT_L(0); PG8_MMA(0, 1, At, B1); PG8_BAR;
            PG8_LDA(At, 1, 1); PG8_STAGE(PG8_SA(1, 0), a3, voffA);
            PG8_BAR; PG8_WAIT_L(0); PG8_MMA(1, 0, At, B0); PG8_BAR; PG8_SCHED;
            PG8_STAGE(PG8_SB(1, 1), b3 + hstep, voffB);
            PG8_WAIT_V(6); PG8_BAR; PG8_MMA(1, 1, At, B1); PG8_BAR;
            }
        }
        if constexpr (ALIGN_EPI) { if (wr == 0) PG8_BAR; }
        if constexpr (!Epi::AFTER_DRAIN) { E(acc, cur, wr, wc, fr, fq); S.done(cur); }
        if (!has_next) break;
#pragma unroll
        for (int a = 0; a < 2; ++a)
#pragma unroll
            for (int b = 0; b < 2; ++b)
#pragma unroll
                for (int m = 0; m < 4; ++m)
#pragma unroll
                    for (int n = 0; n < 2; ++n) acc[a][b][m][n] = (f32x4){0.f, 0.f, 0.f, 0.f};
        cur = nxt; cA = nA; cB = nB; ++ui;
        if constexpr (ALIGN_EPI) { if (wr == 1) PG8_BAR; }
    }
    PG8_WAIT_V(0);
    if constexpr (!ALIGN_EPI) { if (wr == 0) PG8_BAR; }
    PG8_BAR;
    if constexpr (Epi::AFTER_DRAIN) { E.fused(acc, cur, wr, wc, fr, fq, lds, wid, lane); S.done(cur); }
#undef PG8_SA
#undef PG8_SB
#undef PG8_STAGE
#undef PG8_LDA
#undef PG8_LDB
#undef PG8_MMA
#undef PG8_WAIT_V
#undef PG8_WAIT_L
#undef PG8_BAR
#undef PG8_SCHED
}
}

namespace pg8 {
struct EpiStore {
    static constexpr bool PERM = true, AFTER_DRAIN = false;
    bf16_t* O; int ldc;
    __device__ __forceinline__ void operator()(const f32x4 (&acc)[2][2][4][2], const Unit& u, int wr, int wc, int fr, int fq) const {
        const int row0 = u.pm * BM + wr * 64 + fr; const int col0 = u.pn * BM + wc * 32 + 8 * fq;
#pragma unroll
        for (int ai = 0; ai < 2; ++ai)
#pragma unroll
            for (int m = 0; m < 4; ++m) { bf16_t* rowp = O + (size_t)(row0 + ai * HALF + m * 16) * ldc + col0;
#pragma unroll
                for (int bj = 0; bj < 2; ++bj) { const f32x4 v0 = acc[ai][bj][m][0], v1 = acc[ai][bj][m][1];
                    u32x4 w; w.x = cvt_pk_bf16(v0[0], v0[1]); w.y = cvt_pk_bf16(v0[2], v0[3]); w.z = cvt_pk_bf16(v1[0], v1[1]); w.w = cvt_pk_bf16(v1[2], v1[3]);
                    *(u32x4*)(rowp + bj * HALF) = w; } }
    }
};
struct EpiSwiglu {
    static constexpr bool PERM = true, AFTER_DRAIN = false;
    bf16_t* O; int ldc;
    __device__ __forceinline__ void operator()(const f32x4 (&acc)[2][2][4][2], const Unit& u, int wr, int wc, int fr, int fq) const {
        const int row0 = u.pm * BM + wr * 64 + fr; const int col0 = u.pn * HALF + wc * 32 + 8 * fq;
#pragma unroll
        for (int ai = 0; ai < 2; ++ai)
#pragma unroll
            for (int m = 0; m < 4; ++m) { bf16_t* rowp = O + (size_t)(row0 + ai * HALF + m * 16) * ldc + col0;
                float h[8];
#pragma unroll
                for (int n = 0; n < 2; ++n)
#pragma unroll
                    for (int i = 0; i < 4; ++i) { const float g = acc[ai][0][m][n][i], up = acc[ai][1][m][n][i]; h[n * 4 + i] = g * __builtin_amdgcn_rcpf(1.f + __expf(-g)) * up; }
                u32x4 w; w.x = cvt_pk_bf16(h[0], h[1]); w.y = cvt_pk_bf16(h[2], h[3]); w.z = cvt_pk_bf16(h[4], h[5]); w.w = cvt_pk_bf16(h[6], h[7]);
                *(u32x4*)rowp = w; }
    }
};
}

using pg8::bf16_t; using pg8::bf16x8; using pg8::f32x4; using pg8::u32x4;
typedef float f32x16 __attribute__((ext_vector_type(16)));
typedef unsigned u32x2 __attribute__((ext_vector_type(2)));
#define DI __device__ __forceinline__
#define LDSFENCE() asm volatile("s_waitcnt lgkmcnt(0)" ::: "memory")
#define MFMA16(a, b, c) __builtin_amdgcn_mfma_f32_16x16x32_bf16((a), (b), (c), 0, 0, 0)
#define MFMA32(a, b, c) __builtin_amdgcn_mfma_f32_32x32x16_bf16((a), (b), (c), 0, 0, 0)

constexpr int DM = 1024, NB = 8, SL = 4096, NC = 256, TT = SL + NC, MR = NB * TT, DEPTH = 4;
constexpr int DIN = 2320, DINP = 2304, DFF = 2816;
constexpr int NCH = TT / 64, NCH32 = TT / 32;
constexpr int C_AQ = 0, C_AK = 512, C_AV = 640, C_MQ = 768, C_MK = 1024, C_MV = 1280, C_MO = 1536, C_RX = 1792, C_RY = 2048;
constexpr int MIX_ATT = 0, MIX_M = 512, MIX_R = 768;
constexpr float EPS = 1e-6f;
constexpr int NTHR = 512;
constexpr int RG = 5;
constexpr int LDS_BYTES = 147456;

constexpr size_t MiB = 1u << 20;
constexpr size_t WS_WIN = 0, WS_WOUT = 18 * MiB, WS_WF1 = 26 * MiB, WS_WF2 = 70 * MiB;
constexpr size_t WS_MOD = 92 * MiB, WS_ROPE = 93 * MiB, WS_LW = 93 * MiB + 512 * 1024, WS_GS = 94 * MiB, WS_MS = 94 * MiB + 256 * 1024, WS_M0 = 94 * MiB + 512 * 1024;
constexpr size_t WS_NLOC = 95 * MiB, WS_N0 = 97 * MiB, WS_LAGG = 99 * MiB, WS_CARRY = 104 * MiB, WS_GATES = 107 * MiB, WS_XC = 110 * MiB, WS_BAR = 119 * MiB;
constexpr size_t WS_ACT = 120 * MiB, WS_Y = 188 * MiB, WS_C0 = WS_Y, WS_CLOC = 256 * MiB, WS_P = 324 * MiB, WS_END = 511 * MiB;

struct Params {
    const float *x, *c, *ctx, *c_ctx, *w_ada, *b_ada, *norm_gain, *w_in, *w_out, *attn_sink, *mgate_b, *mnorm, *conv_w, *conv_b, *lru_w, *lru_b, *lru_lam, *w_f1, *w_f2;
    float* out; unsigned char* ws; int ph_lo, ph_hi;
};

DI float bf2f(unsigned short v) { return __uint_as_float((unsigned)v << 16); }
DI unsigned short f2bf(float f) { unsigned u = __float_as_uint(f); return (unsigned short)((u + 0x7fffu + ((u >> 16) & 1u)) >> 16); }
typedef __bf16 bf16x2_hw __attribute__((ext_vector_type(2)));
typedef float f32x2_hw __attribute__((ext_vector_type(2)));
DI unsigned pk2(float lo, float hi) { const f32x2_hw v = {lo, hi}; const bf16x2_hw b = __builtin_convertvector(v, bf16x2_hw); return __builtin_bit_cast(unsigned, b); }
DI void unpack8(const u32x4& v, float* f) {
    f[0] = __uint_as_float(v.x << 16); f[1] = __uint_as_float(v.x & 0xffff0000u); f[2] = __uint_as_float(v.y << 16); f[3] = __uint_as_float(v.y & 0xffff0000u);
    f[4] = __uint_as_float(v.z << 16); f[5] = __uint_as_float(v.z & 0xffff0000u); f[6] = __uint_as_float(v.w << 16); f[7] = __uint_as_float(v.w & 0xffff0000u);
}
DI u32x4 pack8(const float* f) { u32x4 w; w.x = pk2(f[0], f[1]); w.y = pk2(f[2], f[3]); w.z = pk2(f[4], f[5]); w.w = pk2(f[6], f[7]); return w; }
DI float wsum(float v) {
#pragma unroll
    for (int o = 32; o; o >>= 1) v += __shfl_xor(v, o);
    return v;
}
DI float wmaxf(float v) {
#pragma unroll
    for (int o = 32; o; o >>= 1) v = fmaxf(v, __shfl_xor(v, o));
    return v;
}
DI float frcp(float x) { return __builtin_amdgcn_rcpf(x); }
DI float sigmoidf_(float x) { return frcp(1.f + __expf(-x)); }
DI float logsigmoidf_(float x) { return fminf(x, 0.f) - log1pf(__expf(-fabsf(x))); }
DI float softplusf_(float x) { return fmaxf(x, 0.f) + log1pf(__expf(-fabsf(x))); }
DI float gelu_tanh(float y) { const float z = 0.7978845608028654f * (y + 0.044715f * y * y * y); const float th = 1.f - 2.f * frcp(__expf(2.f * z) + 1.f); return 0.5f * y * (1.f + th); }
DI float neg_expm1(float x) { const float pl = -x * (1.f + x * (0.5f + x * (0.16666667f + x * (0.041666668f + x * 0.008333334f)))); const float ex = 1.f - __expf(x); return x > -0.25f ? pl : ex; }
DI int crow(int reg, int h) { return (reg & 3) + 8 * (reg >> 2) + 4 * h; }

DI void transpose_tile(const float* src, int ldw, int k0, int srccol0, bf16_t* dst, int ldk, int dstrow0, float* tile) {
    int tid_l = threadIdx.x; asm volatile("" : "+v"(tid_l)); const int tid = tid_l;
    __syncthreads();
#pragma unroll
    for (int i = 0; i < 8; ++i) { const int kk = (tid >> 6) + 8 * i, nn = tid & 63; tile[kk * 65 + nn] = __builtin_nontemporal_load(&src[(size_t)(k0 + kk) * ldw + srccol0 + nn]); }
    __syncthreads();
    const int nn = tid >> 3, kg = tid & 7; float f[8];
#pragma unroll
    for (int j = 0; j < 8; ++j) f[j] = tile[(kg * 8 + j) * 65 + nn];
    *(u32x4*)(dst + (size_t)(dstrow0 + nn) * ldk + k0 + kg * 8) = pack8(f);
}

DI void convert_layer(const Params& p, unsigned char* lds, int l, int first, int nblk) {
    unsigned char* ws = p.ws; asm volatile("" : "+s"(ws));
    float* ldsf = (float*)lds;
    bf16_t* WIN = (bf16_t*)(ws + WS_WIN); bf16_t* WOUT = (bf16_t*)(ws + WS_WOUT); bf16_t* WF1 = (bf16_t*)(ws + WS_WF1); bf16_t* WF2 = (bf16_t*)(ws + WS_WF2);
    const int me = (int)blockIdx.x - first; if (me < 0) return;
    for (int it = me; it < 2944; it += nblk) {
        int rem = it;
        if (rem < 576) { const int kt = rem / 36, nt = rem % 36, dr = nt * 64, sc = dr < 1792 ? dr : dr + 16;
            transpose_tile(p.w_in + (size_t)l * 1024 * DIN, DIN, kt * 64, sc, WIN + (size_t)l * DINP * 1024, 1024, dr, ldsf); }
        else if (rem < 832) { rem -= 576; const int kt = rem / 16, nt = rem % 16;
            transpose_tile(p.w_out + (size_t)l * 1024 * 1024, 1024, kt * 64, nt * 64, WOUT + (size_t)l * 1024 * 1024, 1024, nt * 64, ldsf); }
        else if (rem < 2240) { rem -= 832; const int kt = rem / 88, nt = rem % 88, dr = nt * 64, tl = dr / 256, wi = dr % 256, sc = wi < 128 ? tl * 128 + wi : DFF + tl * 128 + wi - 128;
            transpose_tile(p.w_f1 + (size_t)l * 1024 * 2 * DFF, 2 * DFF, kt * 64, sc, WF1 + (size_t)l * 2 * DFF * 1024, 1024, dr, ldsf); }
        else { rem -= 2240; const int kt = rem / 16, nt = rem % 16;
            transpose_tile(p.w_f2 + (size_t)l * DFF * 1024, 1024, kt * 64, nt * 64, WF2 + (size_t)l * 1024 * DFF, DFF, nt * 64, ldsf); }
    }
}

DI void phase_setup(const Params& p, unsigned char* lds) {
    int tid_l = threadIdx.x; asm volatile("" : "+v"(tid_l)); const int tid = tid_l, G = gridDim.x, bid = blockIdx.x;
    unsigned char* ws = p.ws; asm volatile("" : "+s"(ws));
    float* ldsf = (float*)lds;
    {
        float* sl = ldsf;
        float* red = ldsf + 9 * 1024;
        for (int i = tid; i < 9 * 1024; i += NTHR) { const int bb = i >> 10, k = i & 1023; const float v = bb < 8 ? p.c[bb * 1024 + k] : p.c_ctx[k]; sl[i] = v / (1.f + __expf(-v)); }
        __syncthreads();
        float* MOD = (float*)(ws + WS_MOD);
        for (int it = bid; it < 4 * 192; it += G) {
            const int l = it / 192, n0 = (it % 192) * 32, cc = tid & 31, kg = tid >> 5;
            float acc[9];
#pragma unroll
            for (int bb = 0; bb < 9; ++bb) acc[bb] = 0.f;
            const float* wp = p.w_ada + ((size_t)l * 1024 + kg * 64) * 6144 + n0 + cc;
#pragma unroll 1
            for (int k0 = 0; k0 < 64; k0 += 16) { float w[16];
#pragma unroll
                for (int k = 0; k < 16; ++k) w[k] = __builtin_nontemporal_load(&wp[(size_t)(k0 + k) * 6144]);
#pragma unroll
                for (int k = 0; k < 16; ++k)
#pragma unroll
                    for (int bb = 0; bb < 9; ++bb) acc[bb] += sl[bb * 1024 + kg * 64 + k0 + k] * w[k]; }
#pragma unroll
            for (int bb = 0; bb < 9; ++bb) red[(kg * 9 + bb) * 32 + cc] = acc[bb];
            __syncthreads();
            if (tid < 288) { const int bb = tid >> 5; float s = p.b_ada[l * 6144 + n0 + cc];
                for (int q = 0; q < 16; ++q) s += red[(q * 9 + bb) * 32 + cc];
                const int ci = n0 >> 10, col = (n0 & 1023) + cc; const float* ng = p.norm_gain + (size_t)l * 4 * 1024;
                if (ci == 1) s = ng[col] * (1.f + s); else if (ci == 2) s = s * ng[1024 + col]; else if (ci == 4) s = ng[2048 + col] * (1.f + s); else if (ci == 5) s = s * ng[3072 + col];
                MOD[((size_t)l * 9 + bb) * 6144 + n0 + cc] = s; }
            __syncthreads();
        }
    }
    convert_layer(p, lds, 0, 0, G);
    {
        bf16_t* LW = (bf16_t*)(ws + WS_LW);
        for (int m = bid; m < 64; m += G) transpose_tile(p.lru_w + (size_t)m * 4096, 64, 0, 0, LW + (size_t)m * 4096, 64, 0, ldsf);
    }
    if (bid == G - 1) {
        float* ROPE = (float*)(ws + WS_ROPE);
        for (int i = tid; i < 1024; i += NTHR) { const int pos = i >> 4, fi = i & 15; const float fr = exp2f(-(float)fi * (13.287712379549449f / 16.f)); const float ang = (float)pos * fr;
            const float n = rintf(ang * 0.15915494309189535f); float r = fmaf(-n, 6.28125f, ang); r = fmaf(-n, 1.9353071795864769e-3f, r);
            ROPE[2 * i] = cosf(r); ROPE[2 * i + 1] = sinf(r); }
    }
}

DI void phase_rows(const Params& p, unsigned char* lds, int l, int kind, float brs = 1.f) {
    int tid_l = threadIdx.x; asm volatile("" : "+v"(tid_l)); const int tid = tid_l, lane = tid & 63, wave = __builtin_amdgcn_readfirstlane(tid >> 6);
    unsigned char* ws = p.ws; asm volatile("" : "+s"(ws));
    const float* MOD = (const float*)(ws + WS_MOD);
    bf16_t* ACT = (bf16_t*)(ws + WS_ACT); const bf16_t* Y = (const bf16_t*)(ws + WS_Y); float* XC = (float*)(ws + WS_XC); float* GATES = (float*)(ws + WS_GATES);
    float* wgT = (float*)lds;
    const bool src_in = (l == 0 && kind <= 1);
    const bool has_br = !(kind == 0 && l == 0);
    const int lb = (kind == 0) ? l - 1 : l;
    const int gi_br = (kind == 1) ? 1 : 3, mi_br = (kind == 1) ? 2 : 5;
    const int gi_pre = (kind == 0) ? 0 : 2, mi_sh = (kind == 0) ? 0 : 3;
    __syncthreads();
    if (kind == 0) {
        const float* wsrc = p.w_in + (size_t)l * 1024 * DIN + 1792;
        for (int i = tid; i < 16384; i += NTHR) { const int k = i >> 4, j = i & 15; wgT[j * 1028 + k] = wsrc[(size_t)k * DIN + j]; }
        __syncthreads();
    }
    const int wg = blockIdx.x * 8 + wave, nwv = gridDim.x * 8;
    const int rbeg = (int)((long)wg * MR / nwv), rend = (int)((long)(wg + 1) * MR / nwv);
    int bbc = -1; f32x4 vsh[4], vsc[4], vgt[4];
#pragma unroll
    for (int i = 0; i < 4; ++i) { vsh[i] = (f32x4){0.f, 0.f, 0.f, 0.f}; vsc[i] = vsh[i]; vgt[i] = vsh[i]; }
#pragma unroll 1
    for (int r0 = rbeg; r0 < rend; r0 += RG) {
        int rr_[RG]; bool ok[RG]; size_t xoff[RG]; bool isc[RG]; int bb[RG];
        float xv[RG][4][4]; u32x2 ycur[4], ynxt[4];
#pragma unroll
        for (int q = 0; q < RG; ++q) {
            int r = r0 + q; ok[q] = r < rend; if (!ok[q]) r = r0;
            const int b = r / TT, t = r - b * TT; isc[q] = t < NC; bb[q] = isc[q] ? 8 : b; rr_[q] = r;
            if ((kind == 2 || (kind == 1 && l == DEPTH - 1)) && isc[q]) ok[q] = false;
            xoff[q] = isc[q] ? ((size_t)b * NC + t) * DM : ((size_t)b * SL + (t - NC)) * DM;
            const float* xs = src_in ? (isc[q] ? p.ctx + xoff[q] : p.x + xoff[q]) : (isc[q] ? XC + xoff[q] : p.out + xoff[q]);
#pragma unroll
            for (int i = 0; i < 4; ++i) { const f32x4 v = __builtin_nontemporal_load((const f32x4*)(xs + 4 * lane + 256 * i)); xv[q][i][0] = v.x; xv[q][i][1] = v.y; xv[q][i][2] = v.z; xv[q][i][3] = v.w; }
        }
        if (has_br) { const bf16_t* yr = Y + (size_t)rr_[0] * DM;
#pragma unroll
            for (int i = 0; i < 4; ++i) ycur[i] = __builtin_nontemporal_load((const u32x2*)(yr + 4 * lane + 256 * i)); }
#pragma unroll
        for (int q = 0; q < RG; ++q) {
            const int r = rr_[q];
            __builtin_amdgcn_sched_barrier(0);
            if (has_br && q + 1 < RG) { const bf16_t* yr = Y + (size_t)rr_[q + 1] * DM;
#pragma unroll
                for (int i = 0; i < 4; ++i) ynxt[i] = __builtin_nontemporal_load((const u32x2*)(yr + 4 * lane + 256 * i)); }
            if (bb[q] != bbc) {
                bbc = bb[q];
                if (has_br) { const float* gate = MOD + ((size_t)(lb * 9 + bbc) * 6 + mi_br) * 1024;
#pragma unroll
                    for (int i = 0; i < 4; ++i) vgt[i] = *(const f32x4*)(gate + 4 * lane + 256 * i); }
                if (kind != 2) { const float* sh = MOD + ((size_t)(l * 9 + bbc) * 6 + mi_sh) * 1024;
#pragma unroll
                    for (int i = 0; i < 4; ++i) { vsh[i] = *(const f32x4*)(sh + 4 * lane + 256 * i); vsc[i] = *(const f32x4*)(sh + 1024 + 4 * lane + 256 * i); } }
            }
            if (has_br) {
                float yv[4][4]; float ss = 0.f;
#pragma unroll
                for (int i = 0; i < 4; ++i) { const u32x2 v = ycur[i];
                    yv[i][0] = __uint_as_float(v.x << 16); yv[i][1] = __uint_as_float(v.x & 0xffff0000u); yv[i][2] = __uint_as_float(v.y << 16); yv[i][3] = __uint_as_float(v.y & 0xffff0000u);
#pragma unroll
                    for (int c = 0; c < 4; ++c) ss += yv[i][c] * yv[i][c]; }
                ss = wsum(ss); const float rs = brs * rsqrtf(ss * (1.f / 1024.f) + EPS);
                float* xd = isc[q] ? XC + xoff[q] : p.out + xoff[q];
#pragma unroll
                for (int i = 0; i < 4; ++i) { const f32x4 mv = vgt[i];
                    xv[q][i][0] += mv.x * (yv[i][0] * rs); xv[q][i][1] += mv.y * (yv[i][1] * rs); xv[q][i][2] += mv.z * (yv[i][2] * rs); xv[q][i][3] += mv.w * (yv[i][3] * rs);
                    if (ok[q]) __builtin_nontemporal_store((f32x4){xv[q][i][0], xv[q][i][1], xv[q][i][2], xv[q][i][3]}, (f32x4*)(xd + 4 * lane + 256 * i)); }
            }
            if (kind != 2) {
                float ss = 0.f;
#pragma unroll
                for (int i = 0; i < 4; ++i)
#pragma unroll
                    for (int c = 0; c < 4; ++c) ss += xv[q][i][c] * xv[q][i][c];
                ss = wsum(ss); const float rs = rsqrtf(ss * (1.f / 1024.f) + EPS);
                float hv[4][4];
#pragma unroll
                for (int i = 0; i < 4; ++i) { const f32x4 sv = vsh[i], cv = vsc[i];
                    hv[i][0] = xv[q][i][0] * rs * cv.x + sv.x; hv[i][1] = xv[q][i][1] * rs * cv.y + sv.y; hv[i][2] = xv[q][i][2] * rs * cv.z + sv.z; hv[i][3] = xv[q][i][3] * rs * cv.w + sv.w;
                    u32x2 o; o.x = pk2(hv[i][0], hv[i][1]); o.y = pk2(hv[i][2], hv[i][3]); if (ok[q]) *(u32x2*)(ACT + (size_t)r * DM + 4 * lane + 256 * i) = o; }
                if (kind == 0) {
#pragma unroll
                    for (int i = 0; i < 4; ++i)
#pragma unroll
                        for (int c = 0; c < 4; ++c) xv[q][i][c] = hv[i][c];
                }
            }
            if (has_br && q + 1 < RG) {
#pragma unroll
                for (int i = 0; i < 4; ++i) ycur[i] = ynxt[i]; }
        }
        if (kind == 0) {
#pragma unroll 1
            for (int j0 = 0; j0 < 8; ++j0) {
                float a[RG][2];
#pragma unroll
                for (int q = 0; q < RG; ++q) { a[q][0] = 0.f; a[q][1] = 0.f; }
#pragma unroll
                for (int jj = 0; jj < 2; ++jj)
#pragma unroll
                    for (int i = 0; i < 4; ++i) { const float4 w = *(const float4*)(wgT + (2 * j0 + jj) * 1028 + 4 * lane + 256 * i);
#pragma unroll
                        for (int q = 0; q < RG; ++q) a[q][jj] += xv[q][i][0] * w.x + xv[q][i][1] * w.y + xv[q][i][2] * w.z + xv[q][i][3] * w.w; }
#pragma unroll
                for (int q = 0; q < RG; ++q) {
                    { const bool hi = (lane & 32) != 0; const float send = hi ? a[q][0] : a[q][1], keep = hi ? a[q][1] : a[q][0]; a[q][0] = keep + __shfl_xor(send, 32); }
                    a[q][0] += __shfl_xor(a[q][0], 16); a[q][0] += __shfl_xor(a[q][0], 8); a[q][0] += __shfl_xor(a[q][0], 4); a[q][0] += __shfl_xor(a[q][0], 2); a[q][0] += __shfl_xor(a[q][0], 1);
                    if (ok[q] && (lane & 31) == 0) GATES[(size_t)rr_[q] * 16 + 2 * j0 + (lane >> 5)] = a[q][0];
                }
            }
        }
    }
}

DI void attn_unit(const Params& p, unsigned char* lds, int l, int b, int qb64, int kvh, bool isctx) {
    int tid_l = threadIdx.x; asm volatile("" : "+v"(tid_l)); const int tid = tid_l, lane = tid & 63, wave = __builtin_amdgcn_readfirstlane(tid >> 6);
    const int g = wave >> 1, half = wave & 1, head = kvh * 4 + g, hh = lane >> 5, ql = lane & 31;
    unsigned char* ws = p.ws; asm volatile("" : "+s"(ws));
    const bf16_t* P = (const bf16_t*)(ws + WS_P); bf16_t* MIX = (bf16_t*)(ws + WS_ACT); const float* rope = (const float*)(ws + WS_ROPE);
    bf16_t* Ks = (bf16_t*)lds;
    bf16_t* Vt = (bf16_t*)(lds + 18432);
    const size_t rowb = (size_t)b * TT;
    const int qpos = qb64 * 64 + half * 32 + ql;
    const int tq = (isctx ? 0 : NC) + qpos;
    const int kb0 = qb64 >> 1;
    constexpr float LOG2E = 1.4426950408889634f;
    bf16x8 qf[4];
    {
        const bf16_t* qp = P + (rowb + tq) * DINP + C_AQ + head * 64 + 8 * hh;
        float f[4][8];
#pragma unroll
        for (int kk = 0; kk < 4; ++kk) { const u32x4 raw = __builtin_nontemporal_load((const u32x4*)(qp + 16 * kk)); unpack8(raw, f[kk]); }
        if (!isctx) { const int rr = qpos >> 6, cc = qpos & 63;
#pragma unroll
            for (int j = 0; j < 8; ++j) { const int i = 8 * hh + j; const float2 r1 = *(const float2*)(rope + (rr * 16 + i) * 2), r2 = *(const float2*)(rope + (cc * 16 + i) * 2);
                float x1 = f[0][j], x2 = f[1][j]; f[0][j] = x1 * r1.x - x2 * r1.y; f[1][j] = x2 * r1.x + x1 * r1.y;
                x1 = f[2][j]; x2 = f[3][j]; f[2][j] = x1 * r2.x - x2 * r2.y; f[3][j] = x2 * r2.x + x1 * r2.y; } }
#pragma unroll
        for (int kk = 0; kk < 4; ++kk) {
#pragma unroll
            for (int j = 0; j < 8; ++j) f[kk][j] *= 0.125f * LOG2E;
            qf[kk] = __builtin_bit_cast(bf16x8, pack8(f[kk])); }
    }
    const float sink = p.attn_sink[l * 8 + head] * LOG2E;
    float mrun = sink, lsum = hh == 0 ? 1.f : 0.f;
    f32x16 O[2];
#pragma unroll
    for (int c = 0; c < 2; ++c)
#pragma unroll
        for (int i = 0; i < 16; ++i) O[c][i] = 0.f;

    const int skey = tid >> 2, spart = tid & 3, sc = (spart & 1) + (spart >> 1) * 4;
    u32x4 pra, prb, pv0, pv1;
    int ti = 0;
#define ATT_TILE_ROW(ti_) ((ti_) < 2 ? (ti_) * 128 : NC + (kb0 + (ti_) - 3) * 128)
#define ATT_LOAD(ti_) do { const bf16_t* kp_ = P + (rowb + ATT_TILE_ROW(ti_) + skey) * DINP + C_AK + kvh * 64; pra = *(const u32x4*)(kp_ + 8 * sc); prb = *(const u32x4*)(kp_ + 8 * (sc + 2)); \
        const bf16_t* vp_ = P + (rowb + ATT_TILE_ROW(ti_) + skey) * DINP + C_AV + kvh * 64 + spart * 16; pv0 = *(const u32x4*)vp_; pv1 = *(const u32x4*)(vp_ + 8); } while (0)
    ATT_LOAD(0);
#pragma unroll 1
    while (ti < 5) {
        const bool kctx = ti < 2; const int kb = kb0 + ti - 3; const int kt0 = ATT_TILE_ROW(ti);
        int tn = ti + 1;
        if (isctx) { if (tn >= 2) tn = 5; } else { if (tn == 2 && kb0 == 0) tn = 3; if (tn == 4 && kb0 == 31) tn = 5; }
        __syncthreads();
        {
            u32x4 ra = pra, rb = prb;
            if (!kctx) { float fa[8], fb[8]; unpack8(ra, fa); unpack8(rb, fb); const int pos = kt0 - NC + skey, tp = sc < 2 ? pos >> 6 : pos & 63, ib = 8 * (sc & 1);
#pragma unroll
                for (int j = 0; j < 8; ++j) { const float2 cs = *(const float2*)(rope + (tp * 16 + ib + j) * 2); const float x1 = fa[j], x2 = fb[j]; fa[j] = x1 * cs.x - x2 * cs.y; fb[j] = x2 * cs.x + x1 * cs.y; }
                ra = pack8(fa); rb = pack8(fb); }
            *(u32x4*)(Ks + skey * 72 + 8 * sc) = ra; *(u32x4*)(Ks + skey * 72 + 8 * (sc + 2)) = rb;
            const unsigned vv[8] = {pv0.x, pv0.y, pv0.z, pv0.w, pv1.x, pv1.y, pv1.z, pv1.w};
#pragma unroll
            for (int e = 0; e < 8; ++e) { Vt[(spart * 16 + 2 * e) * 136 + skey] = (bf16_t)(vv[e] & 0xffffu); Vt[(spart * 16 + 2 * e + 1) * 136 + skey] = (bf16_t)(vv[e] >> 16); }
        }
        if (tn < 5) ATT_LOAD(tn);
        __syncthreads();
        const bool domask = (!kctx) && (ti != 3);
        int k2lo = 0, k2hi = 2;
        if (!kctx) { if (ti == 2 && (qb64 & 1)) k2lo = 1; if (ti == 4 && !(qb64 & 1)) k2hi = 1; }
#pragma unroll 1
        for (int k2 = k2lo; k2 < k2hi; ++k2) {
            f32x16 s[2];
#pragma unroll
            for (int ks = 0; ks < 2; ++ks) {
#pragma unroll
                for (int i = 0; i < 16; ++i) s[ks][i] = 0.f;
#pragma unroll
                for (int kk = 0; kk < 4; ++kk) { const bf16x8 ka = *(const bf16x8*)(Ks + (64 * k2 + 32 * ks + ql) * 72 + 16 * kk + 8 * hh); s[ks] = MFMA32(ka, qf[kk], s[ks]); }
            }
            if (domask) {
#pragma unroll
                for (int ks = 0; ks < 2; ++ks)
#pragma unroll
                    for (int i = 0; i < 16; ++i) { const int kpos = kb * 128 + 64 * k2 + 32 * ks + crow(i, hh); const int dd = qpos - kpos; if (dd > 128 || dd < -128) s[ks][i] = -INFINITY; } }
            float tmax = fmaxf(s[0][0], s[1][0]);
#pragma unroll
            for (int i = 1; i < 16; ++i) tmax = fmaxf(tmax, fmaxf(s[0][i], s[1][i]));
            tmax = fmaxf(tmax, __shfl_xor(tmax, 32));
            const float mnew = fmaxf(mrun, tmax), alpha = __builtin_amdgcn_exp2f(mrun - mnew); mrun = mnew;
            float psum = 0.f;
#pragma unroll
            for (int ks = 0; ks < 2; ++ks)
#pragma unroll
                for (int i = 0; i < 16; ++i) { s[ks][i] = __builtin_amdgcn_exp2f(s[ks][i] - mnew); psum += s[ks][i]; }
            lsum = lsum * alpha + psum;
#pragma unroll
            for (int dt = 0; dt < 2; ++dt)
#pragma unroll
                for (int i = 0; i < 16; ++i) O[dt][i] *= alpha;
#pragma unroll
            for (int ks = 0; ks < 2; ++ks)
#pragma unroll
                for (int st = 0; st < 2; ++st) {
                    u32x4 pw; pw.x = pk2(s[ks][8 * st], s[ks][8 * st + 1]); pw.y = pk2(s[ks][8 * st + 2], s[ks][8 * st + 3]); pw.z = pk2(s[ks][8 * st + 4], s[ks][8 * st + 5]); pw.w = pk2(s[ks][8 * st + 6], s[ks][8 * st + 7]);
                    const bf16x8 pb = __builtin_bit_cast(bf16x8, pw);
#pragma unroll
                    for (int dt = 0; dt < 2; ++dt) { const bf16_t* vr = Vt + (32 * dt + ql) * 136 + 64 * k2 + 32 * ks + 16 * st + 4 * hh;
                        const u32x2 a0 = *(const u32x2*)vr, a1 = *(const u32x2*)(vr + 8); u32x4 aw; aw.x = a0.x; aw.y = a0.y; aw.z = a1.x; aw.w = a1.y;
                        O[dt] = MFMA32(__builtin_bit_cast(bf16x8, aw), pb, O[dt]); }
                }
        }
        ti = tn;
    }
#undef ATT_LOAD
#undef ATT_TILE_ROW
    {
        const float ltot = lsum + __shfl_xor(lsum, 32), inv = frcp(ltot);
        bf16_t* op = MIX + (rowb + tq) * DM + MIX_ATT + head * 64;
#pragma unroll
        for (int dt = 0; dt < 2; ++dt)
#pragma unroll
            for (int g4 = 0; g4 < 4; ++g4) { u32x2 o; o.x = pk2(O[dt][4 * g4] * inv, O[dt][4 * g4 + 1] * inv); o.y = pk2(O[dt][4 * g4 + 2] * inv, O[dt][4 * g4 + 3] * inv);
                *(u32x2*)(op + 32 * dt + 8 * g4 + 4 * hh) = o; }
    }
}

DI void stage_rows(const bf16_t* src, bf16_t* dst) {
    int tid_l = threadIdx.x; asm volatile("" : "+v"(tid_l)); const int tid = tid_l;
#pragma unroll
    for (int it = 0; it < 4; ++it) { const int idx = tid + it * NTHR, t = idx >> 5, cg = idx & 31; *(u32x4*)(dst + t * 264 + 8 * cg) = *(const u32x4*)(src + (size_t)t * DINP + 8 * cg); }
}
DI void stage_transposed(const bf16_t* src, bf16_t* dst) {
    int tid_l = threadIdx.x; asm volatile("" : "+v"(tid_l)); const int tid = tid_l;
#pragma unroll
    for (int it = 0; it < 4; ++it) { const int idx = tid + it * NTHR, t = idx & 63, cg = idx >> 6; const u32x4 v = *(const u32x4*)(src + (size_t)t * DINP + 8 * cg);
        const unsigned vv[4] = {v.x, v.y, v.z, v.w};
#pragma unroll
        for (int e = 0; e < 4; ++e) { dst[(8 * cg + 2 * e) * 72 + t] = (bf16_t)(vv[e] & 0xffffu); dst[(8 * cg + 2 * e + 1) * 72 + t] = (bf16_t)(vv[e] >> 16); } }
#pragma unroll
    for (int it = 0; it < 2; ++it) { const int idx = tid + it * NTHR; dst[(256 + (idx >> 6)) * 72 + (idx & 63)] = (bf16_t)0x3F80; }
}
DI float prefix_sum(float v, int lane) {
#pragma unroll
    for (int o = 1; o < 64; o <<= 1) { const float u = __shfl_up(v, o); if (lane >= o) v += u; }
    return v;
}
DI float prefix_max(float v, int lane) {
#pragma unroll
    for (int o = 1; o < 64; o <<= 1) { const float u = __shfl_up(v, o); if (lane >= o) v = fmaxf(v, u); }
    return v;
}

DI void mlstm_local_unit(const Params& p, unsigned char* lds, int l, int b, int c) {
    int tid_l = threadIdx.x; asm volatile("" : "+v"(tid_l)); const int tid = tid_l, lane = tid & 63, wave = __builtin_amdgcn_readfirstlane(tid >> 6), h = wave & 3, d = wave >> 2, fr = lane & 15, fq = lane >> 4;
    unsigned char* ws = p.ws; asm volatile("" : "+s"(ws));
    const bf16_t* P = (const bf16_t*)(ws + WS_P); const float* GATES = (const float*)(ws + WS_GATES);
    float* GS = (float*)(ws + WS_GS); float* MS = (float*)(ws + WS_MS); float* CLOC = (float*)(ws + WS_CLOC); float* NLOC = (float*)(ws + WS_NLOC);
    bf16_t* Kt = (bf16_t*)lds;
    bf16_t* Vt = (bf16_t*)(lds + 36864);
    float* wl = (float*)(lds + 76032) + wave * 64;
    const size_t row0 = (size_t)b * TT + c * 64;
    __syncthreads();
    stage_transposed(P + row0 * DINP + C_MK, Kt);
    stage_transposed(P + row0 * DINP + C_MV, Vt);
    const int tau = d ? 63 - lane : lane;
    const float* G = GATES + (row0 + tau) * 16; const float* gb = p.mgate_b + l * 16;
    const float li = G[(2 * d) * 4 + h] + gb[(2 * d) * 4 + h]; const float lf = logsigmoidf_(G[(2 * d + 1) * 4 + h] + gb[(2 * d + 1) * 4 + h]);
    const float bc = prefix_sum(lf, lane); const float gt = __shfl(bc, 63); const float a = gt - bc + li; const float ml = wmaxf(a); const float w = __expf(a - ml);
    wl[tau] = w;
    const int nd = d ? (c < 4 ? 3 - c : 71 - c) : c; const int sid = (b * 4 + h) * 2 + d;
    if (lane == 0) { GS[sid * NCH + nd] = gt; MS[sid * NCH + nd] = ml; }
    __syncthreads();
    bf16x8 va[4][2];
#pragma unroll
    for (int et = 0; et < 4; ++et)
#pragma unroll
        for (int kk = 0; kk < 2; ++kk) va[et][kk] = *(const bf16x8*)(Vt + (h * 64 + 16 * et + fr) * 72 + 32 * kk + 8 * fq);
    float* outp = CLOC + ((size_t)sid * NCH + nd) * 4096;
#pragma unroll
    for (int dt = 0; dt < 4; ++dt) {
        bf16x8 kb[2];
#pragma unroll
        for (int kk = 0; kk < 2; ++kk) { const u32x4 raw = *(const u32x4*)(Kt + (h * 64 + 16 * dt + fr) * 72 + 32 * kk + 8 * fq); float f[8]; unpack8(raw, f);
            const float4 w0 = *(const float4*)(wl + 32 * kk + 8 * fq), w1 = *(const float4*)(wl + 32 * kk + 8 * fq + 4);
            f[0] *= w0.x; f[1] *= w0.y; f[2] *= w0.z; f[3] *= w0.w; f[4] *= w1.x; f[5] *= w1.y; f[6] *= w1.z; f[7] *= w1.w;
            kb[kk] = __builtin_bit_cast(bf16x8, pack8(f)); }
#pragma unroll
        for (int et = 0; et < 4; ++et) { f32x4 acc = {0.f, 0.f, 0.f, 0.f};
#pragma unroll
            for (int kk = 0; kk < 2; ++kk) acc = MFMA16(va[et][kk], kb[kk], acc);
#pragma unroll
            for (int j = 0; j < 4; ++j) __builtin_nontemporal_store(acc[j] * 0.125f, &outp[(16 * et + 4 * fq + j) * 64 + 16 * dt + fr]); }
    }
    { float s = 0.f; const bf16_t* kr = Kt + (h * 64 + lane) * 72;
#pragma unroll
      for (int t8 = 0; t8 < 8; ++t8) { const u32x4 raw = *(const u32x4*)(kr + 8 * t8); float f[8]; unpack8(raw, f);
#pragma unroll
          for (int j = 0; j < 8; ++j) s += f[j] * wl[8 * t8 + j]; }
      NLOC[((size_t)sid * NCH + nd) * 64 + lane] = s * 0.125f; }
}

DI void mlstm_scan_unit(const Params& p, unsigned char* lds, int u) {
    int tid_l = threadIdx.x; asm volatile("" : "+v"(tid_l)); const int tid = tid_l, sid = u >> 3, slab = u & 7;
    unsigned char* ws = p.ws; asm volatile("" : "+s"(ws));
    const float* GS = (const float*)(ws + WS_GS); const float* MS = (const float*)(ws + WS_MS); float* M0 = (float*)(ws + WS_M0);
    const float* CLOC = (const float*)(ws + WS_CLOC); bf16_t* C0 = (bf16_t*)(ws + WS_C0); const float* NLOC = (const float*)(ws + WS_NLOC); float* N0 = (float*)(ws + WS_N0);
    float* fpv = (float*)lds; float* flv = fpv + 128;
    __syncthreads();
    float* gsv = fpv + 256; float* msv = fpv + 384; float* m0v = fpv + 512;
    if (tid < NCH) { gsv[tid] = GS[sid * NCH + tid]; msv[tid] = MS[sid * NCH + tid]; }
    __syncthreads();
    if (tid == 0) { float m = 0.f;
        for (int j = 0; j < NCH; ++j) { const float g = gsv[j], ml = msv[j]; const float mn = fmaxf(g + m, ml); fpv[j] = __expf(g + m - mn); flv[j] = __expf(ml - mn); m0v[j] = m; m = mn; } }
    __syncthreads();
    if (slab == 0 && tid < NCH) M0[sid * NCH + tid] = m0v[tid];
    { const float* src = CLOC + (size_t)sid * NCH * 4096 + slab * 512 + tid; bf16_t* dst = C0 + (size_t)sid * NCH * 4096 + slab * 512 + tid; float C = 0.f;
#pragma unroll 1
      for (int j0 = 0; j0 < NCH; j0 += 17) { float v[17];
#pragma unroll
          for (int k = 0; k < 17; ++k) v[k] = __builtin_nontemporal_load(&src[(size_t)(j0 + k) * 4096]);
#pragma unroll
          for (int k = 0; k < 17; ++k) { dst[(size_t)(j0 + k) * 4096] = f2bf(C); C = fpv[j0 + k] * C + flv[j0 + k] * v[k]; } } }
    if (slab == 0 && tid < 64) { const float* src = NLOC + (size_t)sid * NCH * 64 + tid; float* dst = N0 + (size_t)sid * NCH * 64 + tid; float C = 0.f;
        for (int j = 0; j < NCH; ++j) { const float v = src[j * 64]; dst[j * 64] = C; C = fpv[j] * C + flv[j] * v; } }
}

DI void mlstm_out_unit(const Params& p, unsigned char* lds, int l, int b, int c) {
    int tid_l = threadIdx.x; asm volatile("" : "+v"(tid_l)); const int tid = tid_l, lane = tid & 63, wave = __builtin_amdgcn_readfirstlane(tid >> 6), h = wave & 3, d = wave >> 2, fr = lane & 15, fq = lane >> 4;
    unsigned char* ws = p.ws; asm volatile("" : "+s"(ws));
    const bf16_t* P = (const bf16_t*)(ws + WS_P); bf16_t* MIX = (bf16_t*)(ws + WS_ACT); const float* GATES = (const float*)(ws + WS_GATES);
    const float* M0 = (const float*)(ws + WS_M0); const bf16_t* C0 = (const bf16_t*)(ws + WS_C0); const float* N0 = (const float*)(ws + WS_N0);
    bf16_t* Vt = (bf16_t*)lds;
    bf16_t* Sp = (bf16_t*)(lds + 39168) + wave * 1152;
    float* scal = (float*)(lds + 57600) + wave * 192;
    float* hbuf = (float*)(lds + 63744);
    const size_t row0 = (size_t)b * TT + c * 64;
    __syncthreads();
    stage_transposed(P + row0 * DINP + C_MV, Vt);
    for (int i = tid; i < 64 * 260; i += NTHR) hbuf[i] = 0.f;
    const int tau = d ? 63 - lane : lane;
    const float* G = GATES + (row0 + tau) * 16; const float* gb = p.mgate_b + l * 16;
    const float li = G[(2 * d) * 4 + h] + gb[(2 * d) * 4 + h]; const float lf = logsigmoidf_(G[(2 * d + 1) * 4 + h] + gb[(2 * d + 1) * 4 + h]);
    const float bc = prefix_sum(lf, lane); const float cs = li - bc; const float mx = prefix_max(cs, lane);
    const int nd = d ? (c < 4 ? 3 - c : 71 - c) : c; const int sid = (b * 4 + h) * 2 + d;
    const float m0 = M0[sid * NCH + nd]; const float mu = fmaxf(mx, m0);
    scal[tau] = cs; scal[64 + tau] = mu; scal[128 + tau] = bc;
    __syncthreads();
    const bf16_t* C0p = C0 + ((size_t)sid * NCH + nd) * 4096; const float* N0p = N0 + ((size_t)sid * NCH + nd) * 64;
    const bf16_t* Qg = P + row0 * DINP + C_MQ + h * 64 + 8 * fq; const bf16_t* Kg = P + row0 * DINP + C_MK + h * 64 + 8 * fq;
    bf16x8 kf[4][2], nf[2], qall[4][2], cfr[4][2];
#pragma unroll
    for (int kk = 0; kk < 2; ++kk) {
#pragma unroll
        for (int ns = 0; ns < 4; ++ns) { kf[ns][kk] = *(const bf16x8*)(Kg + (size_t)(16 * ns + fr) * DINP + 32 * kk); qall[ns][kk] = *(const bf16x8*)(Qg + (size_t)(16 * ns + fr) * DINP + 32 * kk);
            cfr[ns][kk] = *(const bf16x8*)(C0p + (16 * ns + fr) * 64 + 32 * kk + 8 * fq); }
        float f[8];
#pragma unroll
        for (int j = 0; j < 8; ++j) f[j] = N0p[32 * kk + 8 * fq + j];
        nf[kk] = __builtin_bit_cast(bf16x8, pack8(f));
    }
#pragma unroll
    for (int mt = 0; mt < 4; ++mt) {
        bf16x8 qa[2];
#pragma unroll
        for (int kk = 0; kk < 2; ++kk) qa[kk] = qall[mt][kk];
#pragma unroll
        for (int ns = 0; ns < 4; ++ns) { f32x4 s = {0.f, 0.f, 0.f, 0.f};
#pragma unroll
            for (int kk = 0; kk < 2; ++kk) s = MFMA16(qa[kk], kf[ns][kk], s);
            const int sx = 16 * ns + fr; const float csx = scal[sx];
#pragma unroll
            for (int j = 0; j < 4; ++j) { const int t = 16 * mt + 4 * fq + j; const bool ok = d ? (sx >= t) : (sx <= t); const float val = ok ? s[j] * 0.125f * __expf(csx - scal[64 + t]) : 0.f; Sp[(4 * fq + j) * 72 + sx] = f2bf(val); } }
        LDSFENCE();
        f32x4 aS[5], aI[5];
#pragma unroll
        for (int et = 0; et < 5; ++et) { aS[et] = (f32x4){0.f, 0.f, 0.f, 0.f}; aI[et] = (f32x4){0.f, 0.f, 0.f, 0.f}; }
#pragma unroll
        for (int kk = 0; kk < 2; ++kk) { const bf16x8 sa = *(const bf16x8*)(Sp + fr * 72 + 32 * kk + 8 * fq);
#pragma unroll
            for (int et = 0; et < 5; ++et) { const bf16x8 vf = *(const bf16x8*)(Vt + ((et < 4 ? h * 64 + 16 * et : 256) + fr) * 72 + 32 * kk + 8 * fq); aS[et] = MFMA16(sa, vf, aS[et]); }
#pragma unroll
            for (int et = 0; et < 4; ++et) aI[et] = MFMA16(qa[kk], cfr[et][kk], aI[et]);
            aI[4] = MFMA16(qa[kk], nf[kk], aI[4]); }
#pragma unroll
        for (int j = 0; j < 4; ++j) { const int t = 16 * mt + 4 * fq + j; const float mut = scal[64 + t]; const float fi = __expf(m0 - mut); const float den = fi * aI[4][j] + aS[4][j];
            const float lim = __expf(-scal[128 + t] - mut); const float inv = frcp(fmaxf(fabsf(den), lim));
#pragma unroll
            for (int et = 0; et < 4; ++et) atomicAdd(&hbuf[t * 260 + h * 64 + 16 * et + fr], (fi * aI[et][j] + aS[et][j]) * inv); }
        LDSFENCE();
    }
    __syncthreads();
    float ng[4];
#pragma unroll
    for (int h2 = 0; h2 < 4; ++h2) ng[h2] = p.mnorm[l * 256 + h2 * 64 + lane];
#pragma unroll 1
    for (int kb = 0; kb < 32; kb += 8) {
        float ov[8];
#pragma unroll
        for (int k = 0; k < 8; ++k) { const int t = wave * 8 + ((kb + k) >> 2), h2 = k & 3; ov[k] = bf2f(P[(row0 + t) * DINP + C_MO + h2 * 64 + lane]); }
#pragma unroll
        for (int k = 0; k < 8; ++k) { const int t = wave * 8 + ((kb + k) >> 2), h2 = k & 3; const float v = hbuf[t * 260 + h2 * 64 + lane];
            float s1 = v, s2 = v * v;
#pragma unroll
            for (int o = 32; o; o >>= 1) { s1 += __shfl_xor(s1, o); s2 += __shfl_xor(s2, o); }
            const float mean = s1 * (1.f / 64.f); const float var = fmaxf(s2 * (1.f / 64.f) - mean * mean, 0.f);
            const float y = (v - mean) * rsqrtf(var + EPS) * ng[h2];
            MIX[(row0 + t) * DM + MIX_M + h2 * 64 + lane] = f2bf(y * sigmoidf_(ov[k])); }
    }
}

DI void mlstm_out_wave_unit(const Params& p, unsigned char* ldsw, int l, int b, int c, int h, int lane) {
    asm volatile("" : "+v"(lane));
    const int fr = lane & 15, fq = lane >> 4;
    unsigned char* ws = p.ws; asm volatile("" : "+s"(ws));
    const bf16_t* P = (const bf16_t*)(ws + WS_P); bf16_t* MIX = (bf16_t*)(ws + WS_ACT); const float* GATES = (const float*)(ws + WS_GATES);
    const float* M0 = (const float*)(ws + WS_M0); const bf16_t* C0 = (const bf16_t*)(ws + WS_C0); const float* N0 = (const float*)(ws + WS_N0);
    bf16_t* Vt = (bf16_t*)ldsw;
    bf16_t* Sp = (bf16_t*)(ldsw + 11520);
    float* scal = (float*)(ldsw + 13824);
    bf16_t* Ot = (bf16_t*)(ldsw + 15360);
    const size_t row0 = (size_t)b * TT + c * 64;
    LDSFENCE();
#pragma unroll
    for (int cg = 0; cg < 8; ++cg) { const u32x4 v = *(const u32x4*)(P + (row0 + lane) * DINP + C_MV + h * 64 + 8 * cg); const unsigned vv[4] = {v.x, v.y, v.z, v.w};
#pragma unroll
        for (int e = 0; e < 4; ++e) { Vt[(8 * cg + 2 * e) * 72 + lane] = (bf16_t)(vv[e] & 0xffffu); Vt[(8 * cg + 2 * e + 1) * 72 + lane] = (bf16_t)(vv[e] >> 16); } }
#pragma unroll
    for (int i = 0; i < 16; ++i) Vt[(64 + i) * 72 + lane] = (bf16_t)0x3F80;
    const bf16_t* Qg = P + row0 * DINP + C_MQ + h * 64 + 8 * fq; const bf16_t* Kg = P + row0 * DINP + C_MK + h * 64 + 8 * fq;
    bf16x8 kf[4][2];
#pragma unroll
    for (int kk = 0; kk < 2; ++kk)
#pragma unroll
        for (int ns = 0; ns < 4; ++ns) kf[ns][kk] = *(const bf16x8*)(Kg + (size_t)(16 * ns + fr) * DINP + 32 * kk);
    const float* gb = p.mgate_b + l * 16;
    float m0d[2]; const bf16_t* C0d[2]; bf16x8 nf[2][2];
#pragma unroll
    for (int d = 0; d < 2; ++d) {
        const int tau = d ? 63 - lane : lane;
        const float* G = GATES + (row0 + tau) * 16;
        const float li = G[(2 * d) * 4 + h] + gb[(2 * d) * 4 + h]; const float lf = logsigmoidf_(G[(2 * d + 1) * 4 + h] + gb[(2 * d + 1) * 4 + h]);
        const float bc = prefix_sum(lf, lane); const float cs = li - bc; const float mx = prefix_max(cs, lane);
        const int nd = d ? (c < 4 ? 3 - c : 71 - c) : c; const int sid = (b * 4 + h) * 2 + d;
        const float m0 = M0[sid * NCH + nd]; const float mu = fmaxf(mx, m0);
        m0d[d] = m0; C0d[d] = C0 + ((size_t)sid * NCH + nd) * 4096 + fr * 64 + 8 * fq;
        scal[d * 192 + tau] = cs; scal[d * 192 + 64 + tau] = mu; scal[d * 192 + 128 + tau] = bc;
        const float* N0p = N0 + ((size_t)sid * NCH + nd) * 64;
#pragma unroll
        for (int kk = 0; kk < 2; ++kk) { float f[8];
#pragma unroll
            for (int j = 0; j < 8; ++j) f[j] = N0p[32 * kk + 8 * fq + j];
            nf[d][kk] = __builtin_bit_cast(bf16x8, pack8(f)); }
    }
    float ng[4];
#pragma unroll
    for (int et = 0; et < 4; ++et) ng[et] = p.mnorm[l * 256 + h * 64 + 16 * et + fr];
    LDSFENCE();
#pragma unroll 1
    for (int mt = 0; mt < 4; ++mt) {
        bf16x8 qa[2];
#pragma unroll
        for (int kk = 0; kk < 2; ++kk) qa[kk] = *(const bf16x8*)(Qg + (size_t)(16 * mt + fr) * DINP + 32 * kk);
#pragma unroll
        for (int i = 0; i < 2; ++i) { const int idx = lane + 64 * i, tl = idx >> 3, cg = idx & 7; *(u32x4*)(Ot + tl * 72 + 8 * cg) = __builtin_nontemporal_load((const u32x4*)(P + (row0 + 16 * mt + tl) * DINP + C_MO + h * 64 + 8 * cg)); }
        f32x4 hacc[4];
#pragma unroll
        for (int et = 0; et < 4; ++et) hacc[et] = (f32x4){0.f, 0.f, 0.f, 0.f};
#pragma unroll
        for (int d = 0; d < 2; ++d) {
            const float* sc = scal + d * 192;
#pragma unroll
            for (int ns = 0; ns < 4; ++ns) { f32x4 s = {0.f, 0.f, 0.f, 0.f};
#pragma unroll
                for (int kk = 0; kk < 2; ++kk) s = MFMA16(qa[kk], kf[ns][kk], s);
                const int sx = 16 * ns + fr; const float csx = sc[sx];
#pragma unroll
                for (int j = 0; j < 4; ++j) { const int t = 16 * mt + 4 * fq + j; const bool ok = d ? (sx >= t) : (sx <= t); const float val = ok ? s[j] * 0.125f * __expf(csx - sc[64 + t]) : 0.f; Sp[(4 * fq + j) * 72 + sx] = f2bf(val); } }
            LDSFENCE();
            f32x4 aS[5], aI[5];
#pragma unroll
            for (int et = 0; et < 5; ++et) { aS[et] = (f32x4){0.f, 0.f, 0.f, 0.f}; aI[et] = (f32x4){0.f, 0.f, 0.f, 0.f}; }
#pragma unroll
            for (int kk = 0; kk < 2; ++kk) { const bf16x8 sa = *(const bf16x8*)(Sp + fr * 72 + 32 * kk + 8 * fq);
#pragma unroll
                for (int et = 0; et < 5; ++et) { const bf16x8 vf = *(const bf16x8*)(Vt + (16 * et + fr) * 72 + 32 * kk + 8 * fq); aS[et] = MFMA16(sa, vf, aS[et]); }
#pragma unroll
                for (int et = 0; et < 4; ++et) { const bf16x8 cf = *(const bf16x8*)(C0d[d] + et * 1024 + 32 * kk); aI[et] = MFMA16(qa[kk], cf, aI[et]); }
                aI[4] = MFMA16(qa[kk], nf[d][kk], aI[4]); }
#pragma unroll
            for (int j = 0; j < 4; ++j) { const int t = 16 * mt + 4 * fq + j; const float mut = sc[64 + t]; const float fi = __expf(m0d[d] - mut); const float den = fi * aI[4][j] + aS[4][j];
                const float lim = __expf(-sc[128 + t] - mut); const float inv = frcp(fmaxf(fabsf(den), lim));
#pragma unroll
                for (int et = 0; et < 4; ++et) hacc[et][j] += (fi * aI[et][j] + aS[et][j]) * inv; }
            LDSFENCE();
        }
#pragma unroll
        for (int j = 0; j < 4; ++j) { const int tl = 4 * fq + j;
            float s1 = 0.f, s2 = 0.f;
#pragma unroll
            for (int et = 0; et < 4; ++et) { const float v = hacc[et][j]; s1 += v; s2 += v * v; }
#pragma unroll
            for (int o = 1; o < 16; o <<= 1) { s1 += __shfl_xor(s1, o); s2 += __shfl_xor(s2, o); }
            const float mean = s1 * (1.f / 64.f); const float var = fmaxf(s2 * (1.f / 64.f) - mean * mean, 0.f); const float rs = rsqrtf(var + EPS);
#pragma unroll
            for (int et = 0; et < 4; ++et) { const float y = (hacc[et][j] - mean) * rs * ng[et]; const float o = bf2f(Ot[tl * 72 + 16 * et + fr]); Ot[tl * 72 + 16 * et + fr] = f2bf(y * sigmoidf_(o)); } }
        LDSFENCE();
#pragma unroll
        for (int i = 0; i < 2; ++i) { const int idx = lane + 64 * i, tl = idx >> 3, cg = idx & 7; *(u32x4*)(MIX + (row0 + 16 * mt + tl) * DM + MIX_M + h * 64 + 8 * cg) = *(const u32x4*)(Ot + tl * 72 + 8 * cg); }
        LDSFENCE();
    }
}

template <bool FINAL> DI void lru_wave_unit(const Params& p, unsigned char* ldsw, int l, int b, int c, int blk, int lane, int dmask = 3) {
    asm volatile("" : "+v"(lane));
    const int fr = lane & 15, fq = lane >> 4;
    unsigned char* ws = p.ws; asm volatile("" : "+s"(ws));
    const bf16_t* P = (const bf16_t*)(ws + WS_P); bf16_t* MIX = (bf16_t*)(ws + WS_ACT); const bf16_t* LW = (const bf16_t*)(ws + WS_LW);
    float2* LAGG = (float2*)(ws + WS_LAGG); const float* CARRY = (const float*)(ws + WS_CARRY);
    bf16_t* seqb = (bf16_t*)ldsw;
    float2* priv = (float2*)(ldsw + 4608);
    const size_t rowb = (size_t)b * TT; const int t0 = c * 32; const int seg_lo = t0 < NC ? 0 : NC, seg_hi = t0 < NC ? NC : TT;
    const int chs = blk * 64 + lane;
#pragma unroll
    for (int it = 0; it < 4; ++it) { const int idx = lane + 64 * it, tl = idx >> 3, cg = idx & 7, t = t0 + tl, ch0 = blk * 64 + 8 * cg;
        float s[8]; { const float4 b0 = *(const float4*)(p.conv_b + l * 256 + ch0), b1 = *(const float4*)(p.conv_b + l * 256 + ch0 + 4); s[0] = b0.x; s[1] = b0.y; s[2] = b0.z; s[3] = b0.w; s[4] = b1.x; s[5] = b1.y; s[6] = b1.z; s[7] = b1.w; }
#pragma unroll
        for (int j = 0; j < 4; ++j) { const int tt = t + j - 2; if (tt >= seg_lo && tt < seg_hi) { const u32x4 xv = __builtin_nontemporal_load((const u32x4*)(P + (rowb + tt) * DINP + C_RX + ch0)); float f[8]; unpack8(xv, f);
                const float* cw = p.conv_w + (size_t)(l * 4 + j) * 256 + ch0; const float4 w0 = *(const float4*)cw, w1 = *(const float4*)(cw + 4);
                s[0] += w0.x * f[0]; s[1] += w0.y * f[1]; s[2] += w0.z * f[2]; s[3] += w0.w * f[3]; s[4] += w1.x * f[4]; s[5] += w1.y * f[5]; s[6] += w1.z * f[6]; s[7] += w1.w * f[7]; } }
        *(u32x4*)(seqb + tl * 72 + 8 * cg) = pack8(s); }
    LDSFENCE();
    float hreg[32];
#pragma unroll
    for (int d = 0; d < 2; ++d) {
        __builtin_amdgcn_sched_barrier(0);
        if (!FINAL && !((dmask >> d) & 1)) continue;
        const bf16_t* LWp = LW + ((size_t)((l * 2 + d) * 2) * 4 + blk) * 4096 + fr * 64 + 8 * fq;
        float gbr[4], gbi[4], sp8[4];
#pragma unroll
        for (int nt = 0; nt < 4; ++nt) { const int ch = blk * 64 + 16 * nt + fr; gbr[nt] = p.lru_b[(size_t)((l * 2 + d) * 2 + 0) * 256 + ch]; gbi[nt] = p.lru_b[(size_t)((l * 2 + d) * 2 + 1) * 256 + ch];
            sp8[nt] = 8.f * softplusf_(-p.lru_lam[(size_t)(l * 2 + d) * 256 + ch]); }
        const bool small_decay = __builtin_amdgcn_ballot_w64(fmaxf(fmaxf(sp8[0], sp8[1]), fmaxf(sp8[2], sp8[3])) >= 0.12f) == 0ull;
        const int nd = d ? (c < 8 ? 7 - c : 143 - c) : c;
        const size_t aidx = (((size_t)b * NCH32 + nd) * 2 + d) * 256 + chs;
        float hst = FINAL ? CARRY[aidx] : 0.f, ap = 1.f;
#pragma unroll
        for (int mi = 0; mi < 2; ++mi) { const int mt = d ? 1 - mi : mi;
            f32x4 ar[4], ai[4];
#pragma unroll
            for (int nt = 0; nt < 4; ++nt) { ar[nt] = (f32x4){0.f, 0.f, 0.f, 0.f}; ai[nt] = (f32x4){0.f, 0.f, 0.f, 0.f}; }
            { const bf16_t* LWq = LWp; asm volatile("" : "+v"(LWq));
#pragma unroll
            for (int kk = 0; kk < 2; ++kk) { const bf16x8 a = *(const bf16x8*)(seqb + (16 * mt + fr) * 72 + 32 * kk + 8 * fq);
#pragma unroll
                for (int nt = 0; nt < 4; ++nt) { const bf16x8 w0 = *(const bf16x8*)(LWq + nt * 1024 + 32 * kk), w1 = *(const bf16x8*)(LWq + 16384 + nt * 1024 + 32 * kk); ar[nt] = MFMA16(a, w0, ar[nt]); ai[nt] = MFMA16(a, w1, ai[nt]); } } }
#pragma unroll
            for (int nt = 0; nt < 4; ++nt)
#pragma unroll
                for (int jp = 0; jp < 2; ++jp) { const int tl = 4 * fq + 2 * jp;
                    const f32x2_hw xr = (f32x2_hw){ar[nt][2 * jp], ar[nt][2 * jp + 1]} + gbr[nt], xi = (f32x2_hw){ai[nt][2 * jp], ai[nt][2 * jp + 1]} + gbi[nt];
                    const f32x2_hw xr2 = xr * -1.4426950408889634f, xi2 = xi * -1.4426950408889634f;
                    f32x2_hw ex, ey; ex.x = __builtin_amdgcn_exp2f(xr2.x); ex.y = __builtin_amdgcn_exp2f(xr2.y); ey.x = __builtin_amdgcn_exp2f(xi2.x); ey.y = __builtin_amdgcn_exp2f(xi2.y);
                    ex = ex + 1.f; ey = ey + 1.f;
                    const f32x2_hw den = ex * ey; f32x2_hw R; R.x = frcp(den.x); R.y = frcp(den.y);
                    const f32x2_hw r = ey * R, ig = ex * R;
                    const f32x2_hw la = r * -sp8[nt];
                    f32x2_hw a, nem;
                    if (small_decay) { a = la * (la * (la * (la * (la * 0.008333334f + 0.041666668f) + 0.16666667f) + 0.5f) + 1.f) + 1.f; const f32x2_hw x2 = la * 2.f; nem = (x2 * (x2 * (x2 * (x2 * (x2 * 0.008333334f + 0.041666668f) + 0.16666667f) + 0.5f) + 1.f)) * -1.f; }
                    else { a.x = __expf(la.x); a.y = __expf(la.y); nem.x = neg_expm1(2.f * la.x); nem.y = neg_expm1(2.f * la.y); }
                    f32x2_hw sq; sq.x = __builtin_amdgcn_sqrtf(nem.x); sq.y = __builtin_amdgcn_sqrtf(nem.y);
                    const f32x2_hw sv = {bf2f(seqb[(16 * mt + tl) * 72 + 16 * nt + fr]), bf2f(seqb[(16 * mt + tl + 1) * 72 + 16 * nt + fr])};
                    const f32x2_hw u = sq * ig * sv;
                    priv[tl * 64 + 16 * nt + fr] = make_float2(a.x, u.x); priv[(tl + 1) * 64 + 16 * nt + fr] = make_float2(a.y, u.y); }
            LDSFENCE();
#pragma unroll
            for (int ti = 0; ti < 16; ++ti) { const int tl = d ? 15 - ti : ti; const float2 au = priv[tl * 64 + lane]; hst = au.x * hst + au.y; ap *= au.x;
                if (FINAL) { if (d == 0) hreg[16 * mt + tl] = hst; else hreg[16 * mt + tl] += hst; } }
            LDSFENCE();
        }
        if (!FINAL) LAGG[aidx] = make_float2(ap, hst);
    }
    if (FINAL) {
#pragma unroll
        for (int t8 = 0; t8 < 32; t8 += 8) { float yv[8];
#pragma unroll
            for (int t = 0; t < 8; ++t) yv[t] = bf2f(__builtin_nontemporal_load(&P[(rowb + t0 + t8 + t) * DINP + C_RY + chs]));
#pragma unroll
            for (int t = 0; t < 8; ++t) MIX[(rowb + t0 + t8 + t) * DM + MIX_R + chs] = f2bf(hreg[t8 + t] * gelu_tanh(yv[t])); }
    }
}

DI void lru_scan_unit(const Params& p, int b) {
    int tid_l = threadIdx.x; asm volatile("" : "+v"(tid_l)); const int tid = tid_l, d = tid >> 8, ch = tid & 255;
    unsigned char* ws = p.ws; asm volatile("" : "+s"(ws));
    const float2* LAGG = (const float2*)(ws + WS_LAGG); float* CARRY = (float*)(ws + WS_CARRY);
    float carry = 0.f;
#pragma unroll 1
    for (int n0 = 0; n0 < NCH32; n0 += 17) { float2 v[17];
#pragma unroll
        for (int k = 0; k < 17; ++k) v[k] = LAGG[(((size_t)b * NCH32 + n0 + k) * 2 + d) * 256 + ch];
#pragma unroll
        for (int k = 0; k < 17; ++k) { CARRY[(((size_t)b * NCH32 + n0 + k) * 2 + d) * 256 + ch] = carry; carry = v[k].x * carry + v[k].y; } }
}

#define LAS __attribute__((address_space(3)))
#define XB_TMO      128
#define XB_XCNT(j)  (256  + 64 * (j))
#define XB_XSUB(j)  (1280 + 64 * (j))
#define XB_XGEN(j)  (2304 + 64 * (j))
#define XB_TOP      3328
#define XB_TOPGEN   3392
#define XCD_BAR_WORDS 3456
#define XB_SPIN_CAP (1u << 18)

__device__ __forceinline__ unsigned xb_ld(unsigned* p)              { return __hip_atomic_load(p, __ATOMIC_RELAXED, __HIP_MEMORY_SCOPE_AGENT); }
__device__ __forceinline__ unsigned xb_add(unsigned* p, unsigned v) { return __hip_atomic_fetch_add(p, v, __ATOMIC_RELAXED, __HIP_MEMORY_SCOPE_AGENT); }
__device__ __forceinline__ unsigned xb_xcc_id() { return (unsigned)__builtin_amdgcn_s_getreg((3 << 11) | 20) & 0xFu; }
#define XB_SPIN(cond, bar) do { unsigned _sp = 0; while (cond) { __builtin_amdgcn_s_sleep(1); \
    if ((++_sp & 255u) == 0u) { if (xb_ld(&(bar)[XB_TMO])) break; if (_sp > XB_SPIN_CAP) { atomicAdd(&(bar)[XB_TMO], 1u); break; } } } } while (0)

struct XcdBarrier {
    unsigned* bar; unsigned x;
    volatile LAS unsigned* st;
};

__device__ __forceinline__ XcdBarrier xcd_barrier_post(unsigned* bar, volatile LAS unsigned* st) {
    XcdBarrier b; b.bar = bar; b.x = xb_xcc_id(); b.st = st;
    if (threadIdx.x == 0) (void)xb_add(&bar[XB_XCNT(b.x)], 1u);
    return b;
}
__device__ __forceinline__ void xcd_barrier_complete(unsigned* bar, unsigned x, unsigned& nloc, unsigned& nx) {
    const unsigned G = gridDim.x * gridDim.y * gridDim.z;
    unsigned sum, cnt, mine, sp = 0u;
    for (;;) {
        sum = 0u; cnt = 0u; mine = 0u;
#pragma unroll
        for (unsigned j = 0; j < 16; ++j) { const unsigned c = xb_ld(&bar[XB_XCNT(j)]); sum += c; cnt += (c > 0u) ? 1u : 0u; mine = (j == x) ? c : mine; }
        if (sum == G) break;
        __builtin_amdgcn_s_sleep(1);
        if ((++sp & 255u) == 0u) { if (xb_ld(&bar[XB_TMO])) break; if (sp > XB_SPIN_CAP) { atomicAdd(&bar[XB_TMO], 1u); break; } }
    }
    nloc = mine > 0u ? mine : 1u; nx = cnt > 0u ? cnt : 1u;
}

__device__ __forceinline__ void xcd_barrier(const XcdBarrier& b) {
    asm volatile("s_waitcnt vmcnt(0)" ::: "memory");
    __syncthreads();
    if (threadIdx.x == 0) {
        unsigned* bar = b.bar;
        __builtin_amdgcn_s_waitcnt(0);
        unsigned nloc = b.st[0], nx = b.st[1];
        if (nloc == 0u) { xcd_barrier_complete(bar, b.x, nloc, nx); b.st[0] = nloc; b.st[1] = nx; }
        const unsigned old = xb_add(&bar[XB_XSUB(b.x)], 1u);
        const unsigned gen = old / nloc;
        if (old + 1u == (gen + 1u) * nloc) {
            __builtin_amdgcn_fence(__ATOMIC_RELEASE, "agent");
            asm volatile("s_waitcnt vmcnt(0)" ::: "memory");
            const unsigned og = xb_add(&bar[XB_TOP], 1u);
            const unsigned tg = og / nx;
            if (og + 1u == (tg + 1u) * nx) xb_add(&bar[XB_TOPGEN], 1u);
            else XB_SPIN(xb_ld(&bar[XB_TOPGEN]) == tg, bar);
            __builtin_amdgcn_fence(__ATOMIC_ACQUIRE, "agent");
            xb_add(&bar[XB_XGEN(b.x)], 1u);
            asm volatile("s_waitcnt vmcnt(0)" ::: "memory");
        } else {
            XB_SPIN(xb_ld(&bar[XB_XGEN(b.x)]) == gen, bar);
            __builtin_amdgcn_fence(__ATOMIC_ACQUIRE, "agent");
            asm volatile("s_waitcnt vmcnt(0)" ::: "memory");
        }
    }
    __syncthreads();
}

typedef const volatile __attribute__((address_space(4))) Params* KParamsPtr;
DI Params kload() { KParamsPtr kp = (KParamsPtr)__builtin_amdgcn_kernarg_segment_ptr(); Params q;
    q.x = (const float*)kp->x;
    q.c = (const float*)kp->c;
    q.ctx = (const float*)kp->ctx;
    q.c_ctx = (const float*)kp->c_ctx;
    q.w_ada = (const float*)kp->w_ada;
    q.b_ada = (const float*)kp->b_ada;
    q.norm_gain = (const float*)kp->norm_gain;
    q.w_in = (const float*)kp->w_in;
    q.w_out = (const float*)kp->w_out;
    q.attn_sink = (const float*)kp->attn_sink;
    q.mgate_b = (const float*)kp->mgate_b;
    q.mnorm = (const float*)kp->mnorm;
    q.conv_w = (const float*)kp->conv_w;
    q.conv_b = (const float*)kp->conv_b;
    q.lru_w = (const float*)kp->lru_w;
    q.lru_b = (const float*)kp->lru_b;
    q.lru_lam = (const float*)kp->lru_lam;
    q.w_f1 = (const float*)kp->w_f1;
    q.w_f2 = (const float*)kp->w_f2;
    q.out = (float*)kp->out; q.ws = (unsigned char*)kp->ws; q.ph_lo = 0; q.ph_hi = 0; return q; }

__global__ void __launch_bounds__(NTHR, 2) fwd_kernel(Params p) {
    extern __shared__ __attribute__((aligned(16))) unsigned char lds[];
    cg::grid_group grid = cg::this_grid();
    const int lo = p.ph_lo, hi = p.ph_hi;
    volatile LAS unsigned* bst = (volatile LAS unsigned*)((LAS unsigned char*)lds + (LDS_BYTES - 64));
    if (threadIdx.x < 16) bst[threadIdx.x] = 0u;
    __syncthreads();
    (void)xcd_barrier_post((unsigned*)(p.ws + WS_BAR), bst);
    if (lo > 1000) grid.sync();
#ifndef ENMASK
#define ENMASK 0xffff
#endif
#define EN(b) ((ENMASK >> (b)) & 1)
#ifndef DUPMASK
#define DUPMASK 0
#endif
#define REP(b) for (int rep_ = 0; rep_ < 1 + ((DUPMASK >> (b)) & 1); ++rep_)
#define IN(k) (lo <= (k) && (k) < hi)
#ifndef DUPMASK
#define DUPMASK 0
#endif
#define SEAM(k) do { if (IN(k) && IN((k) + 1)) { XcdBarrier xb_; xb_.bar = (unsigned*)(((KParamsPtr)__builtin_amdgcn_kernarg_segment_ptr())->ws + WS_BAR); xb_.x = xb_xcc_id(); xb_.st = (volatile LAS unsigned*)((LAS unsigned char*)lds + (LDS_BYTES - 64)); xcd_barrier(xb_); if ((DUPMASK >> 15) & 1) xcd_barrier(xb_); } } while (0)
#define LAUNDER() const Params q = kload(); int l = l0; unsigned char* ws = q.ws; int G = gridDim.x, bid = blockIdx.x; asm volatile("" : "+s"(l), "+s"(ws), "+s"(G), "+s"(bid))
    if (EN(0) && IN(0)) REP(0) { const Params q = kload(); phase_setup(q, lds); }
    SEAM(0);
#pragma unroll 1
    for (int l0 = 0; l0 < DEPTH; ++l0) {
        const int pb = 1 + 9 * l0;
        if (EN(1) && IN(pb + 0)) REP(1) { LAUNDER(); phase_rows(q, lds, l, 0, rep_ ? 0.f : 1.f); }
        SEAM(pb + 0);
        if (EN(2) && IN(pb + 1)) REP(2) { LAUNDER(); pg8::Gemm g{(bf16_t*)(ws + WS_ACT), (const bf16_t*)(ws + WS_WIN) + (size_t)l * DINP * 1024, MR, DINP, 1024}; pg8::StaticOrder S; S.init(MR, DINP, G, bid); pg8::EpiStore E{(bf16_t*)(ws + WS_P), DINP};
            pg8::gemm_phase<pg8::EpiStore, pg8::StaticOrder, true, true>((PG8_LAS unsigned char*)lds, g, S, E); }
        SEAM(pb + 1);
        if (IN(pb + 2)) REP(3) { LAUNDER();
            const bool need_ctx = l < DEPTH - 1;
            const int nA = 1024 + (need_ctx ? 64 : 0), nM = NB * NCH;
#pragma unroll 1
            for (int u = bid; u < nA + nM; u += G) {
                if (u < 1024) { if (EN(3)) REP(16) attn_unit(q, lds, l, u >> 7, (u >> 1) & 63, u & 1, false); }
                else if (u < nA) { const int v = u - 1024; if (EN(12)) attn_unit(q, lds, l, v >> 3, (v >> 1) & 3, v & 1, true); }
                else { const int v = u - nA; if (EN(10)) REP(10) mlstm_local_unit(q, lds, l, v / NCH, v % NCH); }
            }
            __syncthreads();
            { int tidw = threadIdx.x; asm volatile("" : "+v"(tidw)); const int wave = __builtin_amdgcn_readfirstlane(tidw >> 6), lane = tidw & 63;
              { const int W = G * 8, wr = ((bid + 96) % G) * 8 + wave, nU = NB * NCH32 * 4, nFull = (nU / W) * W;
#pragma unroll 1
                for (int wu = wr; wu < nFull; wu += W) { const int v = wu >> 2; if (EN(9)) REP(9) lru_wave_unit<false>(q, lds + wave * 12800, l, v / NCH32, v % NCH32, wu & 3, lane); }
                if (wr < 2 * (nU - nFull)) { const int wu = nFull + (wr >> 1), v = wu >> 2; if (EN(9)) REP(9) lru_wave_unit<false>(q, lds + wave * 12800, l, v / NCH32, v % NCH32, wu & 3, lane, 1 << (wr & 1)); } } }
        }
        SEAM(pb + 2);
        if (EN(4) && IN(pb + 3)) REP(4) { LAUNDER();
#pragma unroll 1
            for (int u = bid; u < 512 + NB; u += G) { if (u >= NB) mlstm_scan_unit(q, lds, u - NB); else lru_scan_unit(q, u); } }
        SEAM(pb + 3);
        if (IN(pb + 4)) REP(5) { LAUNDER();
            { int tidw = threadIdx.x; asm volatile("" : "+v"(tidw)); const int wave = __builtin_amdgcn_readfirstlane(tidw >> 6), lane = tidw & 63;
              const int nMW = NB * NCH * 4, nLW = NB * NCH32 * 4;
              const int W = G * 8, w = bid * 8 + wave;
              if (W == 2048) {
#pragma unroll 1
                  for (int u = (w + 128) & 2047; u < nMW; u += 2048) { const int v = u >> 2; if (EN(5)) REP(13) mlstm_out_wave_unit(q, lds + wave * 17920, l, v / NCH, v % NCH, u & 3, lane); }
#pragma unroll 1
                  for (int k = 0; k < 3; ++k) {
                      int u = -1;
                      if (w < 1920) { if (k < 2) u = 2 * w + k; else if (w < 384) u = 3968 + w; } else if (k == 0) u = 3840 + (w - 1920);
                      if (u >= 0 && u < nLW) { const int v = u >> 2; if (EN(11)) REP(14) lru_wave_unit<true>(q, lds + wave * 17920, l, v / NCH32, v % NCH32, u & 3, lane); } }
              } else {
#pragma unroll 1
              for (int wu = w; wu < nMW + nLW; wu += W) {
                  if (wu < nMW) { const int v = wu >> 2; if (EN(5)) REP(13) mlstm_out_wave_unit(q, lds + wave * 17920, l, v / NCH, v % NCH, wu & 3, lane); }
                  else { const int w2 = wu - nMW, v = w2 >> 2; if (EN(11)) REP(14) lru_wave_unit<true>(q, lds + wave * 17920, l, v / NCH32, v % NCH32, w2 & 3, lane); } } } }
        }
        SEAM(pb + 4);
        if (EN(6) && IN(pb + 5)) REP(6) { LAUNDER(); __syncthreads(); pg8::Gemm g{(bf16_t*)(ws + WS_ACT), (const bf16_t*)(ws + WS_WOUT) + (size_t)l * 1024 * 1024, MR, 1024, 1024}; pg8::StaticOrder S; S.init(MR, 1024, G, bid, l == DEPTH - 1); pg8::EpiStore E{(bf16_t*)(ws + WS_Y), 1024};
            pg8::gemm_phase<pg8::EpiStore, pg8::StaticOrder, true, true>((PG8_LAS unsigned char*)lds, g, S, E); }
        SEAM(pb + 5);
        if (EN(1) && IN(pb + 6)) for (int rep_ = 0; rep_ < 1 + (((DUPMASK >> 1) & 1) && l0 > 0); ++rep_) { LAUNDER(); phase_rows(q, lds, l, 1, rep_ ? 0.f : 1.f); }
        SEAM(pb + 6);
        if (EN(7) && IN(pb + 7)) REP(7) { LAUNDER(); pg8::Gemm g{(bf16_t*)(ws + WS_ACT), (const bf16_t*)(ws + WS_WF1) + (size_t)l * 2 * DFF * 1024, MR, 2 * DFF, 1024}; pg8::StaticOrder S; S.init(MR, 2 * DFF, G, bid, l == DEPTH - 1); pg8::EpiSwiglu E{(bf16_t*)(ws + WS_P), DFF};
            pg8::gemm_phase<pg8::EpiSwiglu, pg8::StaticOrder, true, true>((PG8_LAS unsigned char*)lds, g, S, E); }
        SEAM(pb + 7);
        if (EN(8) && IN(pb + 8)) REP(8) { LAUNDER(); pg8::Gemm g{(bf16_t*)(ws + WS_P), (const bf16_t*)(ws + WS_WF2) + (size_t)l * 1024 * DFF, MR, 1024, DFF}; pg8::StaticOrder S; S.init(MR, 1024, G, bid, l == DEPTH - 1); pg8::EpiStore E{(bf16_t*)(ws + WS_Y), 1024};
            pg8::gemm_phase<pg8::EpiStore, pg8::StaticOrder, true, true>((PG8_LAS unsigned char*)lds, g, S, E);
            if (rep_ == 0 && l < DEPTH - 1) { __syncthreads(); convert_layer(q, lds, l + 1, 32, G - 32); } }
        SEAM(pb + 8);
    }
    if (EN(1) && IN(37)) { const Params q = kload(); int l = 3; asm volatile("" : "+s"(l)); phase_rows(q, lds, l, 2); }
#undef IN
#undef SEAM
}

#ifndef MK_PER_PHASE
#define MK_PER_PHASE 0
#endif
constexpr int N_PHASES = 38;

extern "C" void kernel_launch(void* const* d_in, const int* in_sizes, int n_in, void* d_out, int out_size, void* d_ws, size_t ws_size, hipStream_t stream) {
    static int grid = 0;
    if (grid == 0) {
        if (n_in != 19 || ws_size < WS_END) { fprintf(stderr, "kernel_launch: unexpected n_in %d or ws_size %zu (need %zu)\n", n_in, ws_size, (size_t)WS_END); grid = -1; return; }
        if (hipFuncSetAttribute((const void*)fwd_kernel, hipFuncAttributeMaxDynamicSharedMemorySize, LDS_BYTES) != hipSuccess) { fprintf(stderr, "kernel_launch: hipFuncSetAttribute failed\n"); grid = -1; return; }
        int dev = 0, cus = 0, per_cu = 0;
        hipGetDevice(&dev); hipDeviceGetAttribute(&cus, hipDeviceAttributeMultiprocessorCount, dev);
        hipOccupancyMaxActiveBlocksPerMultiprocessor(&per_cu, (const void*)fwd_kernel, NTHR, LDS_BYTES);
        if (per_cu < 1) { fprintf(stderr, "kernel_launch: occupancy query says %d blocks per CU\n", per_cu); per_cu = 1; }
        (void)hipGetLastError();
        grid = cus;
    }
    if (grid < 0) return;
    Params p{};
    const float** pp = (const float**)&p;
    for (int i = 0; i < 19; ++i) pp[i] = (const float*)d_in[i];
    p.out = (float*)d_out; p.ws = (unsigned char*)d_ws;
#if MK_PER_PHASE
    for (int k = 0; k < N_PHASES; ++k) { p.ph_lo = k; p.ph_hi = k + 1; hipLaunchKernelGGL(fwd_kernel, dim3(grid), dim3(NTHR), LDS_BYTES, stream, p); }
#else
    p.ph_lo = 0; p.ph_hi = N_PHASES;
    if (hipMemsetAsync((char*)d_ws + WS_BAR, 0, 16384, stream) != hipSuccess) { fprintf(stderr, "kernel_launch: memset failed\n"); return; }
    void* args[] = {&p};
    hipError_t e = hipLaunchCooperativeKernel((const void*)fwd_kernel, dim3(grid), dim3(NTHR), args, LDS_BYTES, stream);
    if (e != hipSuccess) fprintf(stderr, "cooperative launch failed: %s (grid %d)\n", hipGetErrorString(e), grid);
#endif
}
```
